# Optimizing an MI355X kernel written in HIP

```python
import jax, jax.numpy as jnp
from jax import lax
import numpy as np

D_MODEL = 1024
BATCH = 2
SEQ = 8192
DEPTH = 2

CHUNK = 64
PLE_DIM = 256
N_A_LAYERS = DEPTH // 2
N_B_LAYERS = DEPTH - N_A_LAYERS
N_DENSE = (DEPTH + 1) // 2
N_MOE = DEPTH // 2

RET_HEADS = 4
RET_QK_DIM = D_MODEL // RET_HEADS
RET_V_DIM = 2 * RET_QK_DIM
RET_QK_WIDTH = RET_HEADS * RET_QK_DIM
RET_V_WIDTH = RET_HEADS * RET_V_DIM
ROPE_BASE = 10000.0

ATT_HEADS = 16
ATT_HEAD_DIM = D_MODEL // ATT_HEADS
ATT_WIDTH = ATT_HEADS * ATT_HEAD_DIM
LEFT_CHUNKS = 8
BAND = (LEFT_CHUNKS + 1) * CHUNK
REL_CLIP = 256
N_REL = REL_CLIP + CHUNK

D_FF_DENSE = 2816
N_EXPERTS = 8
TOP_K = 2
D_FF_EXPERT = 3584
EPS = 1e-6

kernel_name = 'yoco_retention_chunkband_moe_ple'


def rmsnorm(x, g):
    xf = x.astype(jnp.float32)
    y = xf * lax.rsqrt(jnp.mean(xf * xf, axis=-1, keepdims=True) + EPS)
    return (y * g.astype(jnp.float32)).astype(x.dtype)


def swiglu(x, w_gate, w_up, w_down):
    return (jax.nn.silu(x @ w_gate) * (x @ w_up)) @ w_down


def rotary(x, positions):
    half = x.shape[-1] // 2
    inv_freq = 1.0 / (ROPE_BASE ** jnp.linspace(0.0, 1.0, half, dtype=jnp.float32))
    ang = positions.astype(jnp.float32)[..., None] * inv_freq
    cos = jnp.cos(ang)[:, :, None, :]
    sin = jnp.sin(ang)[:, :, None, :]
    x1 = x[..., :half].astype(jnp.float32)
    x2 = x[..., half:].astype(jnp.float32)
    return jnp.concatenate([x1 * cos - x2 * sin, x1 * sin + x2 * cos], axis=-1).astype(x.dtype)


def chunkwise_retention(q, k, v):
    B, S, H, dk = q.shape
    dv = v.shape[-1]
    nc = S // CHUNK
    lg = jnp.log1p(-jnp.exp2(-5.0 - jnp.arange(H, dtype=jnp.float32)))
    idx = jnp.arange(CHUNK, dtype=jnp.float32)
    diff = idx[:, None] - idx[None, :]
    causal = diff >= 0
    dmask = jnp.where(causal, jnp.exp(jnp.where(causal, diff, 0.0)[None] * lg[:, None, None]), 0.0)
    xi = jnp.exp((idx[:, None] + 1.0) * lg[None, :])
    zeta = jnp.exp((CHUNK - 1.0 - idx)[:, None] * lg[None, :])
    g_chunk = jnp.exp(CHUNK * lg)

    def to_chunks(t):
        return jnp.moveaxis(t.astype(jnp.float32).reshape(B, nc, CHUNK, H, t.shape[-1]), 1, 0)

    def step(state, inp):
        qn, kn, vn = inp
        s = jnp.einsum('bihd,bjhd->bhij', qn, kn) * dmask
        inner = jnp.einsum('bhij,bjhe->bihe', s, vn)
        cross = jnp.einsum('bihd,bhde->bihe', qn, state) * xi[None, :, :, None]
        state = state * g_chunk[None, :, None, None] + jnp.einsum(
            'bjhd,bjhe->bhde', kn * zeta[None, :, :, None], vn)
        return state, inner + cross

    state0 = jnp.zeros((B, H, dk, dv), jnp.float32)
    _, out = lax.scan(step, state0, (to_chunks(q), to_chunks(k), to_chunks(v)))
    return jnp.moveaxis(out, 0, 1).reshape(B, S, H, dv)


def retention_mixer(xn, positions, w_in, gn_gain, w_o):
    B, S, _ = xn.shape
    proj = xn @ w_in
    q, k, v, g = jnp.split(proj, [RET_QK_WIDTH, 2 * RET_QK_WIDTH, 2 * RET_QK_WIDTH + RET_V_WIDTH], axis=-1)
    q = rotary(q.reshape(B, S, RET_HEADS, RET_QK_DIM), positions)
    k = rotary(k.reshape(B, S, RET_HEADS, RET_QK_DIM), positions) * (RET_QK_DIM ** -0.5)
    v = v.reshape(B, S, RET_HEADS, RET_V_DIM)
    o = chunkwise_retention(q, k, v)
    o = rmsnorm(o, gn_gain.reshape(RET_HEADS, RET_V_DIM)).astype(xn.dtype)
    return (jax.nn.silu(g) * o.reshape(B, S, RET_V_WIDTH)) @ w_o


def shared_band_kv(h, norm_kv, w_kv):
    B, S, _ = h.shape
    kv = rmsnorm(h, norm_kv) @ w_kv
    k, v = jnp.split(kv, 2, axis=-1)
    pad = ((0, 0), (LEFT_CHUNKS * CHUNK, 0), (0, 0), (0, 0))
    k = jnp.pad(k.reshape(B, S, ATT_HEADS, ATT_HEAD_DIM), pad)
    v = jnp.pad(v.reshape(B, S, ATT_HEADS, ATT_HEAD_DIM), pad)
    return k, v


def band_attention_mixer(xn, kp, vp, w_q, rel_table, w_o):
    B, S, _ = xn.shape
    nc = S // CHUNK
    q = (xn @ w_q).reshape(B, nc, CHUNK, ATT_HEADS, ATT_HEAD_DIM) * (ATT_HEAD_DIM ** -0.5)
    q = jnp.moveaxis(q, 1, 0)
    qi = np.arange(CHUNK)[:, None]
    kj = np.arange(BAND)[None, :]
    rel = np.clip(qi - kj + LEFT_CHUNKS * CHUNK, -(CHUNK - 1), REL_CLIP) + (CHUNK - 1)
    bias = rel_table[:, rel].astype(jnp.float32)
    k_offset = jnp.arange(BAND) - LEFT_CHUNKS * CHUNK

    def one_chunk(args):
        c, q_c = args
        start = c * CHUNK
        k_band = lax.dynamic_slice_in_dim(kp, start, BAND, axis=1)
        v_band = lax.dynamic_slice_in_dim(vp, start, BAND, axis=1)
        s = jnp.einsum('bihd,bjhd->bhij', q_c, k_band).astype(jnp.float32) + bias
        valid = (start + k_offset) >= 0
        s = jnp.where(valid, s, -jnp.inf)
        a = jax.nn.softmax(s, axis=-1).astype(v_band.dtype)
        return jnp.einsum('bhij,bjhd->bihd', a, v_band)

    o = lax.map(one_chunk, (jnp.arange(nc), q))
    o = jnp.moveaxis(o, 0, 1).reshape(B, S, ATT_WIDTH)
    return o @ w_o


def moe_swiglu(xn, w_router, w_gate, w_up, w_down):
    logits = (xn @ w_router).astype(jnp.float32)
    top_v, top_i = lax.top_k(logits, TOP_K)
    top_w = jax.nn.softmax(top_v, axis=-1)
    gates = jnp.sum(jax.nn.one_hot(top_i, N_EXPERTS, dtype=jnp.float32) * top_w[..., None], axis=-2)
    gates = gates.astype(xn.dtype)
    y = jnp.zeros_like(xn)
    for e in range(N_EXPERTS):
        y = y + gates[..., e:e + 1] * swiglu(xn, w_gate[e], w_up[e], w_down[e])
    return y


def per_layer_embedding(h, p_i, g, w_up, w_gate):
    gate = jax.nn.sigmoid(rmsnorm(h, g) @ w_gate)
    return (p_i @ w_up) * gate


def setup_inputs(seed: int = 0) -> dict:
    key = jax.random.key(seed)
    ks = jax.random.split(key, 26)
    f32 = jnp.float32

    def nrm(k, shape, fan_in):
        return jax.random.normal(k, shape, f32) * (fan_in ** -0.5)

    def gain(k, shape):
        return 1.0 + 0.05 * jax.random.normal(k, shape, f32)

    offsets = jax.random.randint(ks[2], (BATCH, 1), 0, 4096, dtype=jnp.int32)
    positions = offsets + jnp.arange(SEQ, dtype=jnp.int32)[None, :]
    return {
        'x': jax.random.normal(ks[0], (BATCH, SEQ, D_MODEL), f32),
        'p': jax.random.normal(ks[1], (DEPTH, BATCH, SEQ, PLE_DIM), f32),
        'positions': positions,
        'norm_mix': gain(ks[3], (DEPTH, D_MODEL)),
        'norm_ffn': gain(ks[4], (DEPTH, D_MODEL)),
        'norm_ple': gain(ks[5], (DEPTH, D_MODEL)),
        'w_in_a': nrm(ks[6], (N_A_LAYERS, D_MODEL, 2 * RET_QK_WIDTH + 2 * RET_V_WIDTH), D_MODEL),
        'ret_gn': gain(ks[7], (N_A_LAYERS, RET_V_WIDTH)),
        'w_out_a': nrm(ks[8], (N_A_LAYERS, RET_V_WIDTH, D_MODEL), RET_V_WIDTH),
        'norm_kv': gain(ks[9], (D_MODEL,)),
        'w_kv': nrm(ks[10], (D_MODEL, 2 * ATT_WIDTH), D_MODEL),
        'w_q_b': nrm(ks[11], (N_B_LAYERS, D_MODEL, ATT_WIDTH), D_MODEL),
        'rel_bias': 0.2 * jax.random.normal(ks[12], (N_B_LAYERS, ATT_HEADS, N_REL), f32),
        'w_out_b': nrm(ks[13], (N_B_LAYERS, ATT_WIDTH, D_MODEL), ATT_WIDTH),
        'w_gate_dense': nrm(ks[14], (N_DENSE, D_MODEL, D_FF_DENSE), D_MODEL),
        'w_up_dense': nrm(ks[15], (N_DENSE, D_MODEL, D_FF_DENSE), D_MODEL),
        'w_down_dense': nrm(ks[16], (N_DENSE, D_FF_DENSE, D_MODEL), D_FF_DENSE),
        'w_router': nrm(ks[17], (N_MOE, D_MODEL, N_EXPERTS), D_MODEL),
        'w_gate_moe': nrm(ks[18], (N_MOE, N_EXPERTS, D_MODEL, D_FF_EXPERT), D_MODEL),
        'w_up_moe': nrm(ks[19], (N_MOE, N_EXPERTS, D_MODEL, D_FF_EXPERT), D_MODEL),
        'w_down_moe': nrm(ks[20], (N_MOE, N_EXPERTS, D_FF_EXPERT, D_MODEL), D_FF_EXPERT),
        'w_ple_up': nrm(ks[21], (DEPTH, PLE_DIM, D_MODEL), PLE_DIM),
        'w_ple_gate': nrm(ks[22], (DEPTH, D_MODEL, D_MODEL), D_MODEL),
        'norm_final': gain(ks[23], (D_MODEL,)),
    }


def reference(x, p, positions, norm_mix, norm_ffn, norm_ple, w_in_a, ret_gn, w_out_a,
              norm_kv, w_kv, w_q_b, rel_bias, w_out_b, w_gate_dense, w_up_dense, w_down_dense,
              w_router, w_gate_moe, w_up_moe, w_down_moe, w_ple_up, w_ple_gate, norm_final):
    h = x
    kp = None
    vp = None
    for i in range(DEPTH):
        xn = rmsnorm(h, norm_mix[i])
        if i < N_A_LAYERS:
            h = h + retention_mixer(xn, positions, w_in_a[i], ret_gn[i], w_out_a[i])
        else:
            if i == N_A_LAYERS:
                kp, vp = shared_band_kv(h, norm_kv, w_kv)
            j = i - N_A_LAYERS
            h = h + band_attention_mixer(xn, kp, vp, w_q_b[j], rel_bias[j], w_out_b[j])
        xn = rmsnorm(h, norm_ffn[i])
        m = i // 2
        if i % 2 == 0:
            h = h + swiglu(xn, w_gate_dense[m], w_up_dense[m], w_down_dense[m])
        else:
            h = h + moe_swiglu(xn, w_router[m], w_gate_moe[m], w_up_moe[m], w_down_moe[m])
        h = h + per_layer_embedding(h, p[i], norm_ple[i], w_ple_up[i], w_ple_gate[i])
    return rmsnorm(h, norm_final)
```

```cpp
#include <hip/hip_runtime.h>
#include <cstdio>
#include <cstdint>
#ifndef FX_MODE
#define FX_MODE 3
#endif
#define DBG_HI 21
#define DBG_SET 2
#define DBG_SKIP7 0
#define DBG_SNAP_MIB 380
#define DBG_THR 4e-4f
namespace nv {
static void (*g_hook)(int, int, const float*, hipStream_t) = nullptr;
#define NV_HOOK(pt, ptr) do { if (g_hook) g_hook((pt), b, (const float*)(ptr), st); } while (0)
constexpr int S = 8192, D = 1024, NB = 2;
constexpr int RQK = 1024, RV = 2048, DFF = 2816, NE = 8, DFE = 3584, PLE = 256;
constexpr float EPS = 1e-6f;

__device__ __forceinline__ float wave_sum(float v) {
#pragma unroll
    for (int o = 1; o < 64; o <<= 1) v += __shfl_xor(v, o);
    return v;
}
__device__ __forceinline__ float silu_f(float x) { return x / (1.f + __expf(-x)); }
__device__ __forceinline__ float sigmoid_f(float x) { return 1.f / (1.f + __expf(-x)); }

__global__ void __launch_bounds__(256) k_rmsnorm(const float* in, const float* __restrict__ gain, float* out, int rows) {
    const int row = blockIdx.x * 4 + (threadIdx.x >> 6), lane = threadIdx.x & 63;
    if (row >= rows) return;
    const float4* x = (const float4*)(in + (size_t)row * D);
    const float4* g = (const float4*)gain;
    float4 v[4]; float s = 0.f;
#pragma unroll
    for (int j = 0; j < 4; ++j) { v[j] = x[lane + 64 * j]; s += v[j].x * v[j].x + v[j].y * v[j].y + v[j].z * v[j].z + v[j].w * v[j].w; }
    s = wave_sum(s);
    const float r = rsqrtf(s * (1.f / D) + EPS);
    float4* o = (float4*)(out + (size_t)row * D);
#pragma unroll
    for (int j = 0; j < 4; ++j) { const float4 gg = g[lane + 64 * j]; o[lane + 64 * j] = make_float4(v[j].x * r * gg.x, v[j].y * r * gg.y, v[j].z * r * gg.z, v[j].w * r * gg.w); }
}

__global__ void __launch_bounds__(256) k_sgemm(const float* __restrict__ A, int lda, const int* __restrict__ idx, const float* __restrict__ B, int ldb,
                                               float* __restrict__ C, int ldc, int M, const int* __restrict__ cnt, int K, int accum) {
    __shared__ float As[16][68];
    __shared__ float Bs[16][64];
    const int Mv = cnt ? *cnt : M;
    const int m0 = blockIdx.y * 64, n0 = blockIdx.x * 64;
    if (m0 >= Mv) return;
    const int tid = threadIdx.x, tx = tid & 15, ty = tid >> 4;
    float c[4][4];
#pragma unroll
    for (int i = 0; i < 4; ++i)
#pragma unroll
        for (int j = 0; j < 4; ++j) c[i][j] = 0.f;
    const int ar = tid >> 2, ak = (tid & 3) * 4;
    const int arow = m0 + ar; const bool aval = arow < Mv;
    const int asrc = aval ? (idx ? idx[arow] : arow) : 0;
    const float* Ap = A + (size_t)asrc * lda + ak;
    const int bk = tid >> 4, bn = (tid & 15) * 4;
    const float* Bp = B + (size_t)bk * ldb + n0 + bn;
    for (int k0 = 0; k0 < K; k0 += 16) {
        float4 a = make_float4(0.f, 0.f, 0.f, 0.f);
        if (aval) a = *(const float4*)(Ap + k0);
        const float4 b = *(const float4*)(Bp + (size_t)k0 * ldb);
        __syncthreads();
        As[ak + 0][ar] = a.x; As[ak + 1][ar] = a.y; As[ak + 2][ar] = a.z; As[ak + 3][ar] = a.w;
        *(float4*)&Bs[bk][bn] = b;
        __syncthreads();
#pragma unroll
        for (int kk = 0; kk < 16; ++kk) {
            const float4 av = *(const float4*)&As[kk][ty * 4];
            const float4 bv = *(const float4*)&Bs[kk][tx * 4];
            const float aa[4] = {av.x, av.y, av.z, av.w}, bb[4] = {bv.x, bv.y, bv.z, bv.w};
#pragma unroll
            for (int i = 0; i < 4; ++i)
#pragma unroll
                for (int j = 0; j < 4; ++j) c[i][j] += aa[i] * bb[j];
        }
    }
#pragma unroll
    for (int i = 0; i < 4; ++i) {
        const int row = m0 + ty * 4 + i;
        if (row < Mv) {
            float4* cp = (float4*)(C + (size_t)row * ldc + n0 + tx * 4);
            float4 o = make_float4(c[i][0], c[i][1], c[i][2], c[i][3]);
            if (accum) { const float4 old = *cp; o.x += old.x; o.y += old.y; o.z += old.z; o.w += old.w; }
            *cp = o;
        }
    }
}

__global__ void __launch_bounds__(256) k_rotary(float* __restrict__ T, int ld, const int* __restrict__ pos, float scale, int rows) {
    const int g = blockIdx.x * 256 + threadIdx.x;
    if (g >= rows * 512) return;
    const int i = g & 127, h = (g >> 7) & 3, r = g >> 9;
    const float ex = (float)i / 127.0f;
    const float invf = (float)(1.0 / pow(10000.0, (double)ex));
    const float ang = (float)pos[r] * invf;
    double t = (double)ang * 0.15915494309189535;
    t -= rint(t);
    float sn, cs; sincospif(2.0f * (float)t, &sn, &cs);
    float* p = T + (size_t)r * ld + h * 256 + i;
    const float x1 = p[0], x2 = p[128];
    p[0] = (x1 * cs - x2 * sn) * scale;
    p[128] = (x1 * sn + x2 * cs) * scale;
}

__global__ void __launch_bounds__(256) k_retention(const float* __restrict__ q, const float* __restrict__ k, const float* __restrict__ v, int ld, float* __restrict__ o, int ntok) {
    const int w = blockIdx.x * 4 + (threadIdx.x >> 6), lane = threadIdx.x & 63;
    const int h = w >> 6, e = (w & 63) * 8 + (lane >> 3), part = lane & 7;
    const float gamma = 1.0f - exp2f(-5.0f - (float)h);
    float st[32];
#pragma unroll
    for (int d = 0; d < 32; ++d) st[d] = 0.f;
    const float* qp = q + h * 256 + part * 32; const float* kp = k + h * 256 + part * 32; const float* vp = v + h * 512 + e;
    float* op = o + h * 512 + e;
#pragma unroll 2
    for (int t = 0; t < ntok; ++t) {
        const float vv = vp[(size_t)t * ld];
        float dot = 0.f;
#pragma unroll
        for (int d4 = 0; d4 < 8; ++d4) {
            const float4 kk = *(const float4*)(kp + (size_t)t * ld + d4 * 4);
            const float4 qq = *(const float4*)(qp + (size_t)t * ld + d4 * 4);
            st[d4 * 4 + 0] = gamma * st[d4 * 4 + 0] + kk.x * vv; dot += qq.x * st[d4 * 4 + 0];
            st[d4 * 4 + 1] = gamma * st[d4 * 4 + 1] + kk.y * vv; dot += qq.y * st[d4 * 4 + 1];
            st[d4 * 4 + 2] = gamma * st[d4 * 4 + 2] + kk.z * vv; dot += qq.z * st[d4 * 4 + 2];
            st[d4 * 4 + 3] = gamma * st[d4 * 4 + 3] + kk.w * vv; dot += qq.w * st[d4 * 4 + 3];
        }
        dot += __shfl_xor(dot, 1); dot += __shfl_xor(dot, 2); dot += __shfl_xor(dot, 4);
        if (part == 0) op[(size_t)t * RV] = dot;
    }
}

__global__ void __launch_bounds__(256) k_gn_gate(float* __restrict__ o, const float* __restrict__ g, int ldg, const float* __restrict__ gn, int rows) {
    const int w = blockIdx.x * 4 + (threadIdx.x >> 6), lane = threadIdx.x & 63;
    if (w >= rows * 4) return;
    const int r = w >> 2, h = w & 3;
    float4* op = (float4*)(o + (size_t)r * RV + h * 512); const float4* gp = (const float4*)(g + (size_t)r * ldg + h * 512); const float4* nn = (const float4*)(gn + h * 512);
    float4 a = op[lane], b = op[lane + 64];
    float s = a.x * a.x + a.y * a.y + a.z * a.z + a.w * a.w + b.x * b.x + b.y * b.y + b.z * b.z + b.w * b.w;
    s = wave_sum(s);
    const float rr = rsqrtf(s * (1.f / 512.f) + EPS);
    const float4 g0 = gp[lane], g1 = gp[lane + 64], n0 = nn[lane], n1 = nn[lane + 64];
    op[lane] = make_float4(silu_f(g0.x) * a.x * rr * n0.x, silu_f(g0.y) * a.y * rr * n0.y, silu_f(g0.z) * a.z * rr * n0.z, silu_f(g0.w) * a.w * rr * n0.w);
    op[lane + 64] = make_float4(silu_f(g1.x) * b.x * rr * n1.x, silu_f(g1.y) * b.y * rr * n1.y, silu_f(g1.z) * b.z * rr * n1.z, silu_f(g1.w) * b.w * rr * n1.w);
}

__global__ void __launch_bounds__(256) k_swiglu(float* __restrict__ G, const float* __restrict__ U, int ld, int ncols, int rows, const int* __restrict__ cnt) {
    const int Mv = cnt ? *cnt : rows;
    const size_t n4 = (size_t)ncols / 4;
    for (size_t i = (size_t)blockIdx.x * 256 + threadIdx.x; i < (size_t)Mv * n4; i += (size_t)gridDim.x * 256) {
        const size_t r = i / n4, c = (i % n4) * 4;
        float4* gp = (float4*)(G + r * ld + c); const float4 u = *(const float4*)(U + r * ld + c); float4 g = *gp;
        *gp = make_float4(silu_f(g.x) * u.x, silu_f(g.y) * u.y, silu_f(g.z) * u.z, silu_f(g.w) * u.w);
    }
}
__global__ void __launch_bounds__(256) k_ple_add(float* __restrict__ h, const float* __restrict__ up, const float* __restrict__ gate, size_t n4) {
    for (size_t i = (size_t)blockIdx.x * 256 + threadIdx.x; i < n4; i += (size_t)gridDim.x * 256) {
        float4 hh = ((float4*)h)[i]; const float4 u = ((const float4*)up)[i], g = ((const float4*)gate)[i];
        hh.x += u.x * sigmoid_f(g.x); hh.y += u.y * sigmoid_f(g.y); hh.z += u.z * sigmoid_f(g.z); hh.w += u.w * sigmoid_f(g.w);
        ((float4*)h)[i] = hh;
    }
}

__global__ void __launch_bounds__(256) k_band_attn(const float* __restrict__ q, const float* __restrict__ kv, const float* __restrict__ rel, float* __restrict__ o) {
    __shared__ float Ks[64][65];
    __shared__ float Vs[64][65];
    __shared__ float tab[320];
    const int c = blockIdx.x, h = blockIdx.y, tid = threadIdx.x, i = tid >> 2, part = tid & 3;
    for (int t = tid; t < 320; t += 256) tab[t] = rel[h * 320 + t];
    float qr[64], acc[64];
    const float* qp = q + (size_t)(c * 64 + i) * D + h * 64;
#pragma unroll
    for (int d = 0; d < 64; ++d) { qr[d] = qp[d] * 0.125f; acc[d] = 0.f; }
    float mx = -INFINITY, l = 0.f;
    for (int jt = 0; jt < 9; ++jt) {
        const int kc = c - 8 + jt;
        if (kc < 0) continue;
        __syncthreads();
        for (int e = tid; e < 64 * 64; e += 256) { const int r = e >> 6, d = e & 63; const float* src = kv + (size_t)(kc * 64 + r) * 2048 + h * 64 + d; Ks[r][d] = src[0]; Vs[r][d] = src[1024]; }
        __syncthreads();
        for (int kk = 0; kk < 16; ++kk) {
            const int kr = part * 16 + kk;
            float s = 0.f;
#pragma unroll
            for (int d = 0; d < 64; ++d) s += qr[d] * Ks[kr][d];
            int dist = i - kr + 64 * (8 - jt);
            dist = dist < -63 ? -63 : (dist > 256 ? 256 : dist);
            s += tab[dist + 63];
            const float mn = fmaxf(mx, s);
            const float f = __expf(mx - mn), p = __expf(s - mn);
            l = l * f + p;
#pragma unroll
            for (int d = 0; d < 64; ++d) acc[d] = acc[d] * f + p * Vs[kr][d];
            mx = mn;
        }
    }
#pragma unroll
    for (int sft = 1; sft < 4; sft <<= 1) {
        const float mo = __shfl_xor(mx, sft), lo = __shfl_xor(l, sft);
        const float mn = fmaxf(mx, mo), f0 = __expf(mx - mn), f1 = __expf(mo - mn);
        l = l * f0 + lo * f1;
#pragma unroll
        for (int d = 0; d < 64; ++d) { const float ao = __shfl_xor(acc[d], sft); acc[d] = acc[d] * f0 + ao * f1; }
        mx = mn;
    }
    if (part == 0) {
        float* op = o + (size_t)(c * 64 + i) * D + h * 64; const float inv = 1.f / l;
#pragma unroll
        for (int d = 0; d < 64; ++d) op[d] = acc[d] * inv;
    }
}

__global__ void __launch_bounds__(256) k_router(const float* __restrict__ xn, const float* __restrict__ wr, int* __restrict__ cnt, int* __restrict__ lidx, float* __restrict__ lw, int rows) {
    const int row = blockIdx.x * 4 + (threadIdx.x >> 6), lane = threadIdx.x & 63;
    if (row >= rows) return;
    float lg[8];
#pragma unroll
    for (int e = 0; e < 8; ++e) lg[e] = 0.f;
    for (int j = 0; j < 16; ++j) {
        const int kx = lane + 64 * j; const float x = xn[(size_t)row * D + kx];
        const float4 w0 = *(const float4*)(wr + (size_t)kx * 8), w1 = *(const float4*)(wr + (size_t)kx * 8 + 4);
        lg[0] += x * w0.x; lg[1] += x * w0.y; lg[2] += x * w0.z; lg[3] += x * w0.w; lg[4] += x * w1.x; lg[5] += x * w1.y; lg[6] += x * w1.z; lg[7] += x * w1.w;
    }
#pragma unroll
    for (int e = 0; e < 8; ++e) lg[e] = wave_sum(lg[e]);
    if (lane == 0) {
        int e1 = 0; float v1 = lg[0];
#pragma unroll
        for (int e = 1; e < 8; ++e) if (lg[e] > v1) { v1 = lg[e]; e1 = e; }
        int e2 = -1; float v2 = -INFINITY;
#pragma unroll
        for (int e = 0; e < 8; ++e) if (e != e1 && lg[e] > v2) { v2 = lg[e]; e2 = e; }
        const float p2 = __expf(v2 - v1), w1 = 1.f / (1.f + p2), w2 = p2 / (1.f + p2);
        const int s1 = atomicAdd(&cnt[e1], 1); lidx[e1 * rows + s1] = row; lw[e1 * rows + s1] = w1;
        const int s2 = atomicAdd(&cnt[e2], 1); lidx[e2 * rows + s2] = row; lw[e2 * rows + s2] = w2;
    }
}
__global__ void __launch_bounds__(256) k_scatter_add(float* __restrict__ h, const float* __restrict__ Y, const int* __restrict__ idx, const float* __restrict__ w, const int* __restrict__ cnt) {
    const int m = blockIdx.x * 4 + (threadIdx.x >> 6), lane = threadIdx.x & 63;
    if (m >= *cnt) return;
    const float ww = w[m]; float4* hp = (float4*)(h + (size_t)idx[m] * D); const float4* yp = (const float4*)(Y + (size_t)m * D);
#pragma unroll
    for (int j = 0; j < 4; ++j) { float4 a = hp[lane + 64 * j]; const float4 y = yp[lane + 64 * j]; a.x += ww * y.x; a.y += ww * y.y; a.z += ww * y.z; a.w += ww * y.w; hp[lane + 64 * j] = a; }
}

static void sgemm(hipStream_t st, const float* A, int lda, const int* idx, const float* B, int ldb, float* C, int ldc, int M, const int* cnt, int N, int K, int accum) {
    hipLaunchKernelGGL(k_sgemm, dim3(N / 64, (M + 63) / 64), dim3(256), 0, st, A, lda, idx, B, ldb, C, ldc, M, cnt, K, accum);
}

static void forward(void* const* d_in, float* out, unsigned char* ws, hipStream_t st) {
    const float* x = (const float*)d_in[0]; const float* p = (const float*)d_in[1]; const int* positions = (const int*)d_in[2];
    const float* norm_mix = (const float*)d_in[3]; const float* norm_ffn = (const float*)d_in[4]; const float* norm_ple = (const float*)d_in[5];
    const float* w_in_a = (const float*)d_in[6]; const float* ret_gn = (const float*)d_in[7]; const float* w_out_a = (const float*)d_in[8];
    const float* norm_kv = (const float*)d_in[9]; const float* w_kv = (const float*)d_in[10]; const float* w_q_b = (const float*)d_in[11];
    const float* rel_bias = (const float*)d_in[12]; const float* w_out_b = (const float*)d_in[13];
    const float* w_gate_dense = (const float*)d_in[14]; const float* w_up_dense = (const float*)d_in[15]; const float* w_down_dense = (const float*)d_in[16];
    const float* w_router = (const float*)d_in[17]; const float* w_gate_moe = (const float*)d_in[18]; const float* w_up_moe = (const float*)d_in[19]; const float* w_down_moe = (const float*)d_in[20];
    const float* w_ple_up = (const float*)d_in[21]; const float* w_ple_gate = (const float*)d_in[22]; const float* norm_final = (const float*)d_in[23];
    hipMemcpyAsync(out, x, (size_t)NB * S * D * 4, hipMemcpyDeviceToDevice, st);
    const size_t X1 = (size_t)S * D * 4;
    int* cnt = (int*)ws;
    int* lidx = (int*)(ws + 4096);
    float* lw = (float*)(ws + 4096 + 8 * S * 4);
    unsigned char* base = ws + (1u << 20);
    float* xn = (float*)base;
    float* bufA = (float*)(base + X1);
    for (int b = 0; b < NB; ++b) {
        float* h = out + (size_t)b * S * D;
        const int* pos = positions + b * S;
        {
            float* proj = bufA;
            float* o = (float*)((unsigned char*)bufA + 6 * X1);
            hipLaunchKernelGGL(k_rmsnorm, dim3(S / 4), dim3(256), 0, st, (const float*)h, norm_mix, xn, S);
            sgemm(st, xn, D, nullptr, w_in_a, 6144, proj, 6144, S, nullptr, 6144, D, 0);
            hipLaunchKernelGGL(k_rotary, dim3(S * 512 / 256), dim3(256), 0, st, proj, 6144, pos, 1.0f, S);
            hipLaunchKernelGGL(k_rotary, dim3(S * 512 / 256), dim3(256), 0, st, proj + 1024, 6144, pos, 0.0625f, S);
            NV_HOOK(0, proj);
            hipLaunchKernelGGL(k_retention, dim3(64), dim3(256), 0, st, (const float*)proj, (const float*)(proj + 1024), (const float*)(proj + 2048), 6144, o, S);
            NV_HOOK(1, o);
            hipLaunchKernelGGL(k_gn_gate, dim3(S), dim3(256), 0, st, o, (const float*)(proj + 4096), 6144, ret_gn, S);
            sgemm(st, o, 2048, nullptr, w_out_a, D, h, D, S, nullptr, D, 2048, 1);
            NV_HOOK(2, h);
        }
        {
            float* G = bufA; float* U = G + (size_t)S * DFF;
            hipLaunchKernelGGL(k_rmsnorm, dim3(S / 4), dim3(256), 0, st, (const float*)h, norm_ffn, xn, S);
            sgemm(st, xn, D, nullptr, w_gate_dense, DFF, G, DFF, S, nullptr, DFF, D, 0);
            sgemm(st, xn, D, nullptr, w_up_dense, DFF, U, DFF, S, nullptr, DFF, D, 0);
            hipLaunchKernelGGL(k_swiglu, dim3(4096), dim3(256), 0, st, G, (const float*)U, DFF, DFF, S, nullptr);
            sgemm(st, G, DFF, nullptr, w_down_dense, D, h, D, S, nullptr, D, DFF, 1);
            NV_HOOK(3, h);
        }
        for (int layer = 0; layer < 2; ++layer) {
            if (layer == 1) {
                float* kvb = bufA; float* qb = kvb + (size_t)S * 2048; float* ob = qb + (size_t)S * D;
                hipLaunchKernelGGL(k_rmsnorm, dim3(S / 4), dim3(256), 0, st, (const float*)h, norm_kv, xn, S);
                sgemm(st, xn, D, nullptr, w_kv, 2048, kvb, 2048, S, nullptr, 2048, D, 0);
                hipLaunchKernelGGL(k_rmsnorm, dim3(S / 4), dim3(256), 0, st, (const float*)h, norm_mix + D, xn, S);
                sgemm(st, xn, D, nullptr, w_q_b, D, qb, D, S, nullptr, D, D, 0);
                NV_HOOK(5, kvb);
                hipLaunchKernelGGL(k_band_attn, dim3(S / 64, 16), dim3(256), 0, st, (const float*)qb, (const float*)kvb, rel_bias, ob);
                NV_HOOK(6, ob);
                sgemm(st, ob, D, nullptr, w_out_b, D, h, D, S, nullptr, D, D, 1);
                NV_HOOK(7, h);
                float* G = bufA; float* U = G + (size_t)S * DFE; float* Y = U + (size_t)S * DFE;
                hipLaunchKernelGGL(k_rmsnorm, dim3(S / 4), dim3(256), 0, st, (const float*)h, norm_ffn + D, xn, S);
                hipMemsetAsync(cnt, 0, 64, st);
                hipLaunchKernelGGL(k_router, dim3(S / 4), dim3(256), 0, st, (const float*)xn, w_router, cnt, lidx, lw, S);
                for (int e = 0; e < NE; ++e) {
                    const float* wg = w_gate_moe + (size_t)e * D * DFE; const float* wu = w_up_moe + (size_t)e * D * DFE; const float* wd = w_down_moe + (size_t)e * DFE * D;
                    sgemm(st, xn, D, lidx + e * S, wg, DFE, G, DFE, S, cnt + e, DFE, D, 0);
                    sgemm(st, xn, D, lidx + e * S, wu, DFE, U, DFE, S, cnt + e, DFE, D, 0);
                    hipLaunchKernelGGL(k_swiglu, dim3(4096), dim3(256), 0, st, G, (const float*)U, DFE, DFE, S, (const int*)(cnt + e));
                    sgemm(st, G, DFE, nullptr, wd, D, Y, D, S, cnt + e, D, DFE, 0);
                    hipLaunchKernelGGL(k_scatter_add, dim3(S / 4), dim3(256), 0, st, h, (const float*)Y, (const int*)(lidx + e * S), (const float*)(lw + e * S), (const int*)(cnt + e));
                }
            }
            if (layer == 1) NV_HOOK(8, h);
            float* up = bufA; float* gate = up + (size_t)S * D;
            const float* pl = p + ((size_t)layer * NB + b) * S * PLE;
            hipLaunchKernelGGL(k_rmsnorm, dim3(S / 4), dim3(256), 0, st, (const float*)h, norm_ple + layer * D, xn, S);
            sgemm(st, xn, D, nullptr, w_ple_gate + (size_t)layer * D * D, D, gate, D, S, nullptr, D, D, 0);
            sgemm(st, pl, PLE, nullptr, w_ple_up + (size_t)layer * PLE * D, D, up, D, S, nullptr, D, PLE, 0);
            hipLaunchKernelGGL(k_ple_add, dim3(4096), dim3(256), 0, st, h, (const float*)up, (const float*)gate, (size_t)S * D / 4);
            NV_HOOK(layer == 0 ? 4 : 9, h);
        }
        hipLaunchKernelGGL(k_rmsnorm, dim3(S / 4), dim3(256), 0, st, (const float*)h, norm_final, h, S);
        NV_HOOK(10, h);
    }
}
}

namespace fx {
#define LAS __attribute__((address_space(3)))
#define GAS __attribute__((address_space(1)))
typedef unsigned short bf16_t;
typedef short bf16x8 __attribute__((ext_vector_type(8)));
typedef float f32x4 __attribute__((ext_vector_type(4)));
typedef float f32x2 __attribute__((ext_vector_type(2)));
typedef float f32x16 __attribute__((ext_vector_type(16)));
typedef unsigned u32x4 __attribute__((ext_vector_type(4)));
typedef unsigned u32x2 __attribute__((ext_vector_type(2)));
typedef GAS unsigned gu32;
#define RLX_AGENT __ATOMIC_RELAXED, __HIP_MEMORY_SCOPE_AGENT

constexpr int M = 16384, SEQ = 8192, D = 1024;
constexpr float EPS = 1e-6f, LOG2E = 1.4426950408889634f;
constexpr float C2Q = 0.125f * LOG2E;

__device__ __forceinline__ unsigned cvt_pk_bf16(float lo, float hi) { unsigned r; asm volatile("v_cvt_pk_bf16_f32 %0, %1, %2" : "=v"(r) : "v"(lo), "v"(hi)); return r; }
__device__ __forceinline__ float bf_lo(unsigned w) { return __uint_as_float(w << 16); }
__device__ __forceinline__ float bf_hi(unsigned w) { return __uint_as_float(w & 0xffff0000u); }
__device__ __forceinline__ float fexp2(float x) { return __builtin_amdgcn_exp2f(x); }
__device__ __forceinline__ float frcp(float x) { return __builtin_amdgcn_rcpf(x); }
__device__ __forceinline__ float frsq(float x) { return __builtin_amdgcn_rsqf(x); }
__device__ __forceinline__ float sigmoid_f(float x) { return frcp(1.f + fexp2(-LOG2E * x)); }
__device__ __forceinline__ float silu_f(float x) { return x * sigmoid_f(x); }
__device__ __forceinline__ float wave_sum(float v) {
#pragma unroll
    for (int o = 1; o < 64; o <<= 1) v += __shfl_xor(v, o);
    return v;
}
__device__ __forceinline__ float lg2gamma(int h) { return __builtin_amdgcn_logf(1.0f - fexp2(-5.0f - (float)h)); }
__device__ __forceinline__ float sum16(const float* p) {
    const f32x4* q = (const f32x4*)p; const f32x4 a = q[0], b = q[1], c = q[2], d = q[3];
    return (((a[0] + a[1]) + (a[2] + a[3])) + ((b[0] + b[1]) + (b[2] + b[3]))) + (((c[0] + c[1]) + (c[2] + c[3])) + ((d[0] + d[1]) + (d[2] + d[3])));
}
__device__ __forceinline__ float rstd16(const float* part, int tok) { return frsq(sum16(part + (size_t)tok * 16) * (1.f / 1024.f) + EPS); }

constexpr int BM = 256, BK = 64, HALF = 128, HTB = HALF * BK * 2, STAGE_BYTES = 8 * HTB;
__host__ __device__ __forceinline__ int lds_byte(int r, int c) { const int st = (r >> 4) * 2 + (c >> 5), rr = r & 15, cc = c & 31, ob = rr * 64 + cc * 2; return st * 1024 + (ob ^ (((ob >> 9) & 1) << 5)); }
__host__ __device__ __forceinline__ void stage_rc(int b, int& R, int& C) { const int st = b / 1024, sb = b % 1024, swz = sb ^ (((sb >> 9) & 1) << 5); R = (st >> 1) * 16 + swz / 64; C = (st & 1) * 32 + (swz % 64) / 2; }
__host__ __device__ __forceinline__ int perm32(int rho) { const int n = rho >> 4, i = rho & 15; return 8 * (i >> 2) + 4 * n + (i & 3); }

struct Unit { int pm, pn, kind, ex, lim; };

__device__ __forceinline__ void lin_tile(int nM, int nN, int L, int& pm, int& pn) {
    const int nwg = nM * nN;
    int wgid = L; { const int q = nwg / 8, r = nwg % 8, xcd = wgid % 8, off = wgid / 8; wgid = (xcd < r ? xcd * (q + 1) : r * (q + 1) + (xcd - r) * q) + off; }
    const int nig = 8 * nN, gid = wgid / nig, fm = gid * 8, gsz = (nM - fm) < 8 ? (nM - fm) : 8;
    pm = fm + ((wgid % nig) % gsz); pn = (wgid % nig) / gsz;
}

template <class Epi, class Sched, bool SEG2, bool GATHER>
__device__ __forceinline__ void gemm_phase(LAS unsigned char* lds, const int lda, const int ldb, const int nt, const int nt0, const Sched& S, const Epi& E) {
    int tid_o = threadIdx.x; asm volatile("" : "+v"(tid_o));
    const int tid = tid_o, wid = __builtin_amdgcn_readfirstlane(tid >> 6), lane = tid & 63, wr = wid >> 2, wc = wid & 3, fr = lane & 15, fq = lane >> 4;
    unsigned voffA[2], voffB[2]; int RA[2], CA[2];
#pragma unroll
    for (int i = 0; i < 2; ++i) { int R, C; stage_rc(tid * 16 + i * 8192, R, C); const int Rb = Epi::PERM ? ((R & ~31) + perm32(R & 31)) : R;
        voffA[i] = (unsigned)(R * lda + C) * 2u; voffB[i] = (unsigned)(Rb * ldb + C) * 2u; RA[i] = R; CA[i] = C; }
    const size_t kstep = (size_t)(BK * 2);
    const size_t hstepA = (size_t)HALF * lda * 2, hstepB = (size_t)HALF * ldb * 2;
    const unsigned ldsw = (unsigned)wid * 1024u;
    const int aoff = lds_byte(wr * 64 + fr, fq * 8), boff = lds_byte(wc * 32 + fr, fq * 8);
#define FG_SA(b, h) (((b) * 2 + (h)) * HTB)
#define FG_SB(b, h) ((4 + (b) * 2 + (h)) * HTB)
#define FG_STAGE2(bufoff, gbase, o0, o1) do { \
        __builtin_amdgcn_global_load_lds((const unsigned*)((const char*)(gbase) + (o0)), (LAS unsigned*)(lds + (bufoff) + ldsw), 16, 0, 0); \
        __builtin_amdgcn_global_load_lds((const unsigned*)((const char*)(gbase) + (o1)), (LAS unsigned*)(lds + (bufoff) + ldsw + 8192), 16, 0, 0); } while (0)
#define FG_STB(bufoff, gbase) FG_STAGE2(bufoff, gbase, voffB[0], voffB[1])
#define FG_STA(bufoff, gbase, h, vg) do { if constexpr (GATHER) { FG_STAGE2(bufoff, gbase, vg[h][0], vg[h][1]); } else { FG_STAGE2(bufoff, (gbase) + (h) * hstepA, voffA[0], voffA[1]); } } while (0)
#define FG_LDA(dst, b, h) do { _Pragma("unroll") for (int m = 0; m < 4; ++m) _Pragma("unroll") for (int k = 0; k < 2; ++k) dst[m][k] = *(const LAS bf16x8*)(lds + FG_SA(b, h) + aoff + m * 2048 + k * 1024); } while (0)
#define FG_LDB(dst, b, h) do { _Pragma("unroll") for (int n = 0; n < 2; ++n) _Pragma("unroll") for (int k = 0; k < 2; ++k) dst[n][k] = *(const LAS bf16x8*)(lds + FG_SB(b, h) + boff + n * 2048 + k * 1024); } while (0)
#define FG_MMA(ai, bj, At, Bt) do { __builtin_amdgcn_s_setprio(1); _Pragma("unroll") for (int m = 0; m < 4; ++m) _Pragma("unroll") for (int n = 0; n < 2; ++n) _Pragma("unroll") for (int k = 0; k < 2; ++k) \
        acc[ai][bj][m][n] = __builtin_amdgcn_mfma_f32_16x16x32_bf16(Bt[n][k], At[m][k], acc[ai][bj][m][n], 0, 0, 0); __builtin_amdgcn_s_setprio(0); } while (0)
#define FG_WAIT_V(n) asm volatile("s_waitcnt vmcnt(" #n ")" ::: "memory")
#define FG_WAIT_L(n) asm volatile("s_waitcnt lgkmcnt(" #n ")" ::: "memory")
#define FG_BAR __builtin_amdgcn_s_barrier()
#define FG_SCHED __builtin_amdgcn_sched_barrier(0)
#define FG_KT(s0, d, t) ((s0) + (size_t)(t) * kstep + ((SEG2 && (t) >= nt0) ? (d) : 0l))
    Unit cur, nxt; int ui = 0;
    if (!S.next(0, cur)) return;
    f32x4 acc[2][2][4][2];
#pragma unroll
    for (int a = 0; a < 2; ++a)
#pragma unroll
        for (int b = 0; b < 2; ++b)
#pragma unroll
            for (int m = 0; m < 4; ++m)
#pragma unroll
                for (int n = 0; n < 2; ++n) acc[a][b][m][n] = (f32x4){0.f, 0.f, 0.f, 0.f};
    bf16x8 At[4][2], B0[2][2], B1[2][2];
    const char* cA0 = S.pa(cur); const char* cB0 = S.pb(cur);
    long dA = 0, dB = 0;
    if constexpr (SEG2) { dA = S.dA() - (long)nt0 * (long)kstep; dB = S.dB() - (long)nt0 * (long)kstep; }
    unsigned vgc[2][2], vgn[2][2], vgs[2][2];
    if constexpr (GATHER) {
#pragma unroll
        for (int h = 0; h < 2; ++h)
#pragma unroll
            for (int i = 0; i < 2; ++i) { vgc[h][i] = (unsigned)(S.arow(cur, h * HALF + RA[i]) * lda + CA[i]) * 2u; vgn[h][i] = vgc[h][i]; vgs[h][i] = vgc[h][i]; }
    } else {
#pragma unroll
        for (int h = 0; h < 2; ++h)
#pragma unroll
            for (int i = 0; i < 2; ++i) { vgc[h][i] = 0u; vgn[h][i] = 0u; vgs[h][i] = 0u; }
    }
    FG_STB(FG_SB(0, 0), cB0); FG_STB(FG_SB(0, 1), cB0 + hstepB); FG_STA(FG_SA(0, 0), cA0, 0, vgc); FG_STA(FG_SA(0, 1), cA0, 1, vgc);
    if (wr == 1) FG_BAR;
    FG_WAIT_V(2); FG_BAR;
    FG_STB(FG_SB(1, 0), cB0 + kstep); FG_STA(FG_SA(1, 0), cA0 + kstep, 0, vgc); FG_STB(FG_SB(1, 1), cB0 + hstepB + kstep);
    FG_WAIT_V(6); FG_BAR;
    for (;;) {
        const bool has_next = S.next(ui + 1, nxt);
        const char* nA0 = has_next ? S.pa(nxt) : cA0; const char* nB0 = has_next ? S.pb(nxt) : cB0;
        if constexpr (GATHER) {
            if (has_next) {
#pragma unroll
                for (int h = 0; h < 2; ++h)
#pragma unroll
                    for (int i = 0; i < 2; ++i) vgn[h][i] = (unsigned)(S.arow(nxt, h * HALF + RA[i]) * lda + CA[i]) * 2u;
            }
        }
        for (int t = 0; t < nt; t += 2) {
            const bool last = (t == nt - 2);
            const char* a1 = FG_KT(cA0, dA, t + 1);
            const char* a2 = last ? nA0 : FG_KT(cA0, dA, t + 2); const char* b2 = last ? nB0 : FG_KT(cB0, dB, t + 2);
            const char* a3 = a2 + kstep; const char* b3 = b2 + kstep;
            if constexpr (GATHER) {
#pragma unroll
                for (int h = 0; h < 2; ++h)
#pragma unroll
                    for (int i = 0; i < 2; ++i) vgs[h][i] = last ? vgn[h][i] : vgc[h][i];
            }
            FG_LDB(B0, 0, 0); FG_LDB(B1, 0, 1); FG_SCHED; FG_LDA(At, 0, 0); FG_STA(FG_SA(1, 1), a1, 1, vgc);
            FG_WAIT_V(8); FG_WAIT_L(0); FG_BAR; FG_MMA(0, 0, At, B0); FG_MMA(0, 1, At, B1); FG_BAR; FG_SCHED;
            FG_LDA(At, 0, 1); FG_STB(FG_SB(0, 0), b2); FG_STB(FG_SB(0, 1), b2 + hstepB); FG_STA(FG_SA(0, 0), a2, 0, vgs);
            FG_WAIT_V(8); FG_WAIT_L(0); FG_BAR; FG_MMA(1, 0, At, B0); FG_MMA(1, 1, At, B1); FG_BAR; FG_SCHED;
            FG_LDB(B0, 1, 0); FG_LDB(B1, 1, 1); FG_SCHED; FG_LDA(At, 1, 0); FG_STA(FG_SA(0, 1), a2, 1, vgs);
            FG_WAIT_V(8); FG_WAIT_L(0); FG_BAR; FG_MMA(0, 0, At, B0); FG_MMA(0, 1, At, B1); FG_BAR; FG_SCHED;
            FG_LDA(At, 1, 1); FG_STB(FG_SB(1, 0), b3); FG_STB(FG_SB(1, 1), b3 + hstepB); FG_STA(FG_SA(1, 0), a3, 0, vgs);
            FG_WAIT_V(8); FG_WAIT_L(0); FG_BAR; FG_MMA(1, 0, At, B0); FG_MMA(1, 1, At, B1); FG_BAR; FG_SCHED;
        }
        if (wr == 0) FG_BAR;
        { int fr_o = fr, fq_o = fq; asm volatile("" : "+v"(fr_o), "+v"(fq_o));
          E(acc, cur, wr, wc, fr_o, fq_o); }
        if (!has_next) break;
#pragma unroll
        for (int a = 0; a < 2; ++a)
#pragma unroll
            for (int b = 0; b < 2; ++b)
#pragma unroll
                for (int m = 0; m < 4; ++m)
#pragma unroll
                    for (int n = 0; n < 2; ++n) acc[a][b][m][n] = (f32x4){0.f, 0.f, 0.f, 0.f};
        cur = nxt; cA0 = nA0; cB0 = nB0; ++ui;
        if constexpr (GATHER) {
#pragma unroll
            for (int h = 0; h < 2; ++h)
#pragma unroll
                for (int i = 0; i < 2; ++i) vgc[h][i] = vgn[h][i];
        }
        if (wr == 1) FG_BAR;
    }
    FG_WAIT_V(0);
    FG_BAR;
#undef FG_SA
#undef FG_SB
#undef FG_STAGE2
#undef FG_STB
#undef FG_STA
#undef FG_LDA
#undef FG_LDB
#undef FG_MMA
#undef FG_WAIT_V
#undef FG_WAIT_L
#undef FG_BAR
#undef FG_SCHED
#undef FG_KT
}

struct SchedGen {
    int G, c, nM, nN; const char* A; const char* B; const char* A2; const char* B2; long a_pm, a_pn, b_pm, b_pn; int a_pn_shift, b_pm_shift;
    __device__ __forceinline__ bool next(int i, Unit& u) const { const long L = (long)i * G + c; if (L >= (long)nM * nN) return false; lin_tile(nM, nN, (int)L, u.pm, u.pn); u.kind = 0; u.ex = 0; u.lim = 0; return true; }
    __device__ __forceinline__ long offa(const Unit& u) const { return (long)u.pm * a_pm + (long)(u.pn >> a_pn_shift) * a_pn; }
    __device__ __forceinline__ long offb(const Unit& u) const { return (long)(u.pm >> b_pm_shift) * b_pm + (long)u.pn * b_pn; }
    __device__ __forceinline__ const char* pa(const Unit& u) const { return A + offa(u); }
    __device__ __forceinline__ const char* pb(const Unit& u) const { return B + offb(u); }
    __device__ __forceinline__ long dA() const { return (long)(A2 - A); }
    __device__ __forceinline__ long dB() const { return (long)(B2 - B); }
    __device__ __forceinline__ int arow(const Unit&, int r) const { return r; }
};
struct SchedINA {
    int G, c; const char* hb; const char* W;
    __device__ __forceinline__ bool next(int i, Unit& u) const {
        long L = (long)i * G + c; u.ex = 0; u.lim = 0;
        if (L < 1024) { lin_tile(64, 16, (int)L, u.pm, u.pn); u.kind = u.pn < 4 ? 0 : (u.pn < 8 ? 1 : 2); return true; }
        L -= 1024; if (L >= 768) return false;
        lin_tile(12, 64, (int)L, u.pm, u.pn); u.kind = u.pm < 4 ? 3 : 4; return true;
    }
    __device__ __forceinline__ const char* pa(const Unit& u) const { return u.kind < 3 ? hb + (size_t)u.pm * (256 * 1024 * 2) : W + (size_t)(1024 + u.pm * 256) * 2048; }
    __device__ __forceinline__ const char* pb(const Unit& u) const { return u.kind < 3 ? W + (size_t)((u.pn < 8 ? u.pn : u.pn + 8) * 256) * 2048 : hb + (size_t)u.pn * (256 * 1024 * 2); }
    __device__ __forceinline__ long dA() const { return 0; }
    __device__ __forceinline__ long dB() const { return 0; }
    __device__ __forceinline__ int arow(const Unit&, int r) const { return r; }
};
struct SchedQKVB {
    int G, c; const char* hb; const char* W;
    __device__ __forceinline__ bool next(int i, Unit& u) const {
        long L = (long)i * G + c; u.ex = 0; u.lim = 0;
        if (L < 512) { lin_tile(64, 8, (int)L, u.pm, u.pn); u.kind = u.pn < 4 ? 0 : 1; return true; }
        L -= 512; if (L >= 256) return false;
        lin_tile(4, 64, (int)L, u.pm, u.pn); u.kind = 2; return true;
    }
    __device__ __forceinline__ const char* pa(const Unit& u) const { return u.kind < 2 ? hb + (size_t)u.pm * (256 * 1024 * 2) : W + (size_t)(2048 + u.pm * 256) * 2048; }
    __device__ __forceinline__ const char* pb(const Unit& u) const { return u.kind < 2 ? W + (size_t)(u.pn * 256) * 2048 : hb + (size_t)u.pn * (256 * 1024 * 2); }
    __device__ __forceinline__ long dA() const { return 0; }
    __device__ __forceinline__ long dB() const { return 0; }
    __device__ __forceinline__ int arow(const Unit&, int r) const { return r; }
};
struct SchedMoe {
    int G, c, nN; int c0, c1, c2, c3, c4, c5, c6, c7; int RT;
    const char* A; const char* B; long b_e, b_pn, a_rt; const int* tok;
    __device__ __forceinline__ void init_counts(const unsigned* cnt) {
        c0 = (int)cnt[0]; c1 = (int)cnt[1]; c2 = (int)cnt[2]; c3 = (int)cnt[3]; c4 = (int)cnt[4]; c5 = (int)cnt[5]; c6 = (int)cnt[6]; c7 = (int)cnt[7];
        RT = ((c0 + 255) >> 8) + ((c1 + 255) >> 8) + ((c2 + 255) >> 8) + ((c3 + 255) >> 8) + ((c4 + 255) >> 8) + ((c5 + 255) >> 8) + ((c6 + 255) >> 8) + ((c7 + 255) >> 8);
    }
    __device__ __forceinline__ bool next(int i, Unit& u) const {
        const long L = (long)i * G + c; if (L >= (long)RT * nN) return false;
        lin_tile(RT, nN, (int)L, u.pm, u.pn);
        int e = 0, base = 0, ce = c0, t = (c0 + 255) >> 8;
#define MOE_STEP(k, ck) if (u.pm >= t) { e = k; base = t; ce = ck; } t += (ck + 255) >> 8;
        MOE_STEP(1, c1) MOE_STEP(2, c2) MOE_STEP(3, c3) MOE_STEP(4, c4) MOE_STEP(5, c5) MOE_STEP(6, c6) MOE_STEP(7, c7)
#undef MOE_STEP
        u.kind = e; u.ex = u.pm - base; u.lim = ce - u.ex * 256; return true;
    }
    __device__ __forceinline__ const char* pa(const Unit& u) const { return A + (long)u.pm * a_rt; }
    __device__ __forceinline__ const char* pb(const Unit& u) const { return B + (long)u.kind * b_e + (long)u.pn * b_pn; }
    __device__ __forceinline__ long dA() const { return 0; }
    __device__ __forceinline__ long dB() const { return 0; }
    __device__ __forceinline__ int arow(const Unit& u, int r) const { return r < u.lim ? tok[u.kind * 16384 + u.ex * 256 + r] : 0; }
};
#define EPI_ARGS const f32x4 (&acc)[2][2][4][2], const Unit& u, int wr, int wc, int fr, int fq
__device__ __forceinline__ u32x4 pack8(const float (&o)[8]) { u32x4 w; w.x = cvt_pk_bf16(o[0], o[1]); w.y = cvt_pk_bf16(o[2], o[3]); w.z = cvt_pk_bf16(o[4], o[5]); w.w = cvt_pk_bf16(o[6], o[7]); return w; }

struct EpiINA {
    static constexpr bool PERM = true;
    const float* rstd0; const f32x2* rope; bf16_t *Q, *Kp, *Gt, *KT, *VT;
    __device__ __forceinline__ void operator()(EPI_ARGS) const {
        if (u.kind <= 1) {
            const int h = u.kind == 0 ? u.pn : u.pn - 4; bf16_t* dst = u.kind == 0 ? Q : Kp; const float lg = lg2gamma(h);
#pragma unroll
            for (int ai = 0; ai < 2; ++ai)
#pragma unroll
                for (int m = 0; m < 4; ++m) {
                    const int tok = u.pm * 256 + ai * 128 + wr * 64 + m * 16 + fr;
                    float sc = rstd0[tok]; if (u.kind == 1) sc *= 0.0625f * fexp2(-(float)((tok & 255) + 1) * lg);
                    const int i0 = wc * 32 + fq * 8;
                    const f32x4* rp = (const f32x4*)(rope + (size_t)tok * 128 + i0);
                    f32x4 rr[4]; rr[0] = rp[0]; rr[1] = rp[1]; rr[2] = rp[2]; rr[3] = rp[3];
                    float o1[8], o2[8];
#pragma unroll
                    for (int n = 0; n < 2; ++n)
#pragma unroll
                        for (int j = 0; j < 4; ++j) { const int t = 4 * n + j; const float cs = rr[t >> 1][(t & 1) * 2], sn = rr[t >> 1][(t & 1) * 2 + 1];
                            const float x1 = acc[ai][0][m][n][j], x2 = acc[ai][1][m][n][j]; o1[t] = (x1 * cs - x2 * sn) * sc; o2[t] = (x1 * sn + x2 * cs) * sc; }
                    bf16_t* p = dst + (size_t)tok * 1024 + h * 256 + i0;
                    *(u32x4*)p = pack8(o1); *(u32x4*)(p + 128) = pack8(o2);
                }
        } else if (u.kind == 2) {
#pragma unroll
            for (int ai = 0; ai < 2; ++ai)
#pragma unroll
                for (int m = 0; m < 4; ++m) {
                    const int tok = u.pm * 256 + ai * 128 + wr * 64 + m * 16 + fr; const float rs = rstd0[tok];
#pragma unroll
                    for (int bj = 0; bj < 2; ++bj) { float o[8];
#pragma unroll
                        for (int n = 0; n < 2; ++n)
#pragma unroll
                            for (int j = 0; j < 4; ++j) o[4 * n + j] = silu_f(rs * acc[ai][bj][m][n][j]);
                        *(u32x4*)(Gt + (size_t)tok * 2048 + (u.pn - 8) * 256 + bj * 128 + wc * 32 + fq * 8) = pack8(o); }
                }
        } else if (u.kind == 3) {
            const int h = u.pm; const float lg = lg2gamma(h);
#pragma unroll
            for (int bj = 0; bj < 2; ++bj) {
                const int tok0 = u.pn * 256 + bj * 128 + wc * 32 + fq * 8; float sc[8];
#pragma unroll
                for (int t = 0; t < 8; ++t) sc[t] = rstd0[tok0 + t] * 0.0625f * fexp2(-(float)(((tok0 + t) & 255) + 1) * lg);
#pragma unroll
                for (int m = 0; m < 4; ++m) {
                    const int i = wr * 64 + m * 16 + fr; float o1[8], o2[8];
#pragma unroll
                    for (int n = 0; n < 2; ++n)
#pragma unroll
                        for (int j = 0; j < 4; ++j) { const int t = 4 * n + j; const f32x2 cs = rope[(size_t)(tok0 + t) * 128 + i];
                            const float x1 = acc[0][bj][m][n][j], x2 = acc[1][bj][m][n][j]; o1[t] = (x1 * cs[0] - x2 * cs[1]) * sc[t]; o2[t] = (x1 * cs[1] + x2 * cs[0]) * sc[t]; }
                    *(u32x4*)(KT + (size_t)(h * 256 + i) * M + tok0) = pack8(o1); *(u32x4*)(KT + (size_t)(h * 256 + 128 + i) * M + tok0) = pack8(o2);
                }
            }
        } else {
            const int vrow0 = (u.pm - 4) * 256;
#pragma unroll
            for (int bj = 0; bj < 2; ++bj) {
                const int tok0 = u.pn * 256 + bj * 128 + wc * 32 + fq * 8; float sc[8];
#pragma unroll
                for (int t = 0; t < 8; ++t) sc[t] = rstd0[tok0 + t];
#pragma unroll
                for (int ai = 0; ai < 2; ++ai)
#pragma unroll
                    for (int m = 0; m < 4; ++m) { float o[8];
#pragma unroll
                        for (int n = 0; n < 2; ++n)
#pragma unroll
                            for (int j = 0; j < 4; ++j) o[4 * n + j] = acc[ai][bj][m][n][j] * sc[4 * n + j];
                        *(u32x4*)(VT + (size_t)(vrow0 + ai * 128 + wr * 64 + m * 16 + fr) * M + tok0) = pack8(o); }
            }
        }
    }
};
struct EpiStore {
    static constexpr bool PERM = true;
    bf16_t* O; int ld; int causal;
    __device__ __forceinline__ void operator()(EPI_ARGS) const {
#pragma unroll
        for (int ai = 0; ai < 2; ++ai)
#pragma unroll
            for (int m = 0; m < 4; ++m) {
                const int r = ai * 128 + wr * 64 + m * 16 + fr;
#pragma unroll
                for (int bj = 0; bj < 2; ++bj) { const int c0 = bj * 128 + wc * 32 + fq * 8; float o[8];
                    float fd = causal ? (float)(r - c0 + 1) : 1024.f;
                    asm volatile("" : "+v"(fd));
#pragma unroll
                    for (int n = 0; n < 2; ++n)
#pragma unroll
                        for (int j = 0; j < 4; ++j) { const int t = 4 * n + j; o[t] = acc[ai][bj][m][n][j] * __builtin_amdgcn_fmed3f(fd - (float)t, 0.f, 1.f); }
                    *(u32x4*)(O + (size_t)(u.pm * 256 + r) * ld + u.pn * 256 + c0) = pack8(o); }
            }
    }
};
struct EpiR3 {
    static constexpr bool PERM = true;
    bf16_t* O; float* pgn;
    __device__ __forceinline__ void operator()(EPI_ARGS) const {
        const float lg = lg2gamma(u.pn >> 1);
#pragma unroll
        for (int ai = 0; ai < 2; ++ai)
#pragma unroll
            for (int m = 0; m < 4; ++m) {
                const int r = ai * 128 + wr * 64 + m * 16 + fr, tok = u.pm * 256 + r; const float xi = fexp2((float)(r + 1) * lg); float ss = 0.f;
#pragma unroll
                for (int bj = 0; bj < 2; ++bj) { float o[8];
#pragma unroll
                    for (int n = 0; n < 2; ++n)
#pragma unroll
                        for (int j = 0; j < 4; ++j) { const float v = acc[ai][bj][m][n][j] * xi; o[4 * n + j] = v; ss += v * v; }
                    *(u32x4*)(O + (size_t)tok * 2048 + u.pn * 256 + bj * 128 + wc * 32 + fq * 8) = pack8(o); }
                ss += __shfl_xor(ss, 16); ss += __shfl_xor(ss, 32);
                if (fq == 0) pgn[(size_t)tok * 32 + u.pn * 4 + wc] = ss;
            }
    }
};
template <int MODE> struct EpiRes {
    static constexpr bool PERM = false;
    const float* Hin; float* H; bf16_t* HB; float* pout; const float* pin; const bf16_t* U;
    __device__ __forceinline__ void operator()(EPI_ARGS) const {
#pragma unroll
        for (int ai = 0; ai < 2; ++ai)
#pragma unroll
            for (int m = 0; m < 4; ++m) {
                const int tok = u.pm * 256 + ai * 128 + wr * 64 + m * 16 + fr; float ss = 0.f; float rs = 1.f;
                if (MODE == 1) rs = rstd16(pin, tok);
#pragma unroll
                for (int bj = 0; bj < 2; ++bj)
#pragma unroll
                    for (int n = 0; n < 2; ++n) {
                        const size_t off = (size_t)tok * 1024 + u.pn * 256 + bj * 128 + wc * 32 + n * 16 + fq * 4;
                        f32x4 v = *(const f32x4*)(Hin + off); const f32x4 a = acc[ai][bj][m][n];
                        if (MODE == 1) { const u32x2 uu = *(const u32x2*)(U + off);
                            v[0] += bf_lo(uu.x) * sigmoid_f(rs * a[0]); v[1] += bf_hi(uu.x) * sigmoid_f(rs * a[1]); v[2] += bf_lo(uu.y) * sigmoid_f(rs * a[2]); v[3] += bf_hi(uu.y) * sigmoid_f(rs * a[3]);
                        } else v = v + a;
                        *(f32x4*)(H + off) = v; ss += (v[0] * v[0] + v[1] * v[1]) + (v[2] * v[2] + v[3] * v[3]);
                        if (HB) { u32x2 w; w.x = cvt_pk_bf16(v[0], v[1]); w.y = cvt_pk_bf16(v[2], v[3]); *(u32x2*)(HB + off) = w; }
                    }
                ss += __shfl_xor(ss, 16); ss += __shfl_xor(ss, 32);
                if (fq == 0) pout[(size_t)tok * 16 + u.pn * 4 + wc] = ss;
            }
    }
};
template <bool MOE> struct EpiGU {
    static constexpr bool PERM = true;
    bf16_t* Hd; int ld; const float* pin; const float* rsr; const float* gwr;
    __device__ __forceinline__ void operator()(EPI_ARGS) const {
#pragma unroll
        for (int ai = 0; ai < 2; ++ai)
#pragma unroll
            for (int m = 0; m < 4; ++m) {
                const int r = ai * 128 + wr * 64 + m * 16 + fr, row = u.pm * 256 + r; float rs, gw = 1.f; bool valid = true;
                if (MOE) { valid = r < u.lim; const int ix = u.kind * 16384 + u.ex * 256 + r; rs = valid ? rsr[ix] : 0.f; gw = valid ? gwr[ix] : 0.f; }
                else rs = rstd16(pin, row);
                float o[8];
#pragma unroll
                for (int n = 0; n < 2; ++n)
#pragma unroll
                    for (int j = 0; j < 4; ++j) o[4 * n + j] = silu_f(rs * acc[ai][0][m][n][j]) * (rs * acc[ai][1][m][n][j]) * gw;
                if (valid) *(u32x4*)(Hd + (size_t)row * ld + u.pn * 128 + wc * 32 + fq * 8) = pack8(o);
            }
    }
};
struct EpiQKVB {
    static constexpr bool PERM = true;
    const float* pin; bf16_t *Qb, *Kb, *VbT;
    __device__ __forceinline__ void operator()(EPI_ARGS) const {
        if (u.kind < 2) {
            bf16_t* dst = u.kind == 0 ? Qb : Kb; const float s0 = u.kind == 0 ? C2Q : 1.f;
#pragma unroll
            for (int ai = 0; ai < 2; ++ai)
#pragma unroll
                for (int m = 0; m < 4; ++m) {
                    const int tok = u.pm * 256 + ai * 128 + wr * 64 + m * 16 + fr; const float rs = rstd16(pin, tok) * s0;
#pragma unroll
                    for (int bj = 0; bj < 2; ++bj) { float o[8];
#pragma unroll
                        for (int n = 0; n < 2; ++n)
#pragma unroll
                            for (int j = 0; j < 4; ++j) o[4 * n + j] = rs * acc[ai][bj][m][n][j];
                        *(u32x4*)(dst + (size_t)tok * 1024 + (u.pn & 3) * 256 + bj * 128 + wc * 32 + fq * 8) = pack8(o); }
                }
        } else {
#pragma unroll
            for (int bj = 0; bj < 2; ++bj) {
                const int tok0 = u.pn * 256 + bj * 128 + wc * 32 + fq * 8; float sc[8];
#pragma unroll
                for (int t = 0; t < 8; ++t) sc[t] = rstd16(pin, tok0 + t);
#pragma unroll
                for (int ai = 0; ai < 2; ++ai)
#pragma unroll
                    for (int m = 0; m < 4; ++m) { float o[8];
#pragma unroll
                        for (int n = 0; n < 2; ++n)
#pragma unroll
                            for (int j = 0; j < 4; ++j) o[4 * n + j] = acc[ai][bj][m][n][j] * sc[4 * n + j];
                        *(u32x4*)(VbT + (size_t)(u.pm * 256 + ai * 128 + wr * 64 + m * 16 + fr) * M + tok0) = pack8(o); }
            }
        }
    }
};

struct TCtx { LAS unsigned char* lds; int tid, lane, wave, vcu, G; };

__device__ __forceinline__ void cvt_item(const float* __restrict__ W, int N, const float* __restrict__ gain, bf16_t* __restrict__ dst, int dld, int mode, int row_off, LAS float* scr, int item, int lane) {
    const int nblk = N / 32, kb = item / nblk, nb = item % nblk, k0 = 64 * kb, n0 = 32 * nb;
#pragma unroll 8
    for (int i = 0; i < 32; ++i) { const int kk = 2 * i + (lane >> 5); float v = W[(size_t)(k0 + kk) * N + n0 + (lane & 31)]; if (gain) v *= gain[k0 + kk]; scr[kk * 33 + (lane & 31)] = v; }
    asm volatile("s_waitcnt lgkmcnt(0)" ::: "memory");
    const int c = lane & 7;
#pragma unroll
    for (int j = 0; j < 4; ++j) { const int n = (lane >> 3) + 8 * j; const LAS float* s = scr + (8 * c) * 33 + n;
        u32x4 o; o.x = cvt_pk_bf16(s[0 * 33], s[1 * 33]); o.y = cvt_pk_bf16(s[2 * 33], s[3 * 33]); o.z = cvt_pk_bf16(s[4 * 33], s[5 * 33]); o.w = cvt_pk_bf16(s[6 * 33], s[7 * 33]);
        const int nn = n0 + n; const int drow = mode ? ((nn >> 7) << 8) + (nn & 127) + row_off : row_off + nn;
        *(u32x4*)(dst + (size_t)drow * dld + k0 + 8 * c) = o; }
    asm volatile("s_waitcnt lgkmcnt(0)" ::: "memory");
}
struct CvtJob { const float* W; const float* gain; bf16_t* dst; int K, N, dld, mode, row_off; };
__device__ __forceinline__ int cvt_items(const CvtJob& j) { return (j.K / 64) * (j.N / 32); }
constexpr size_t MiB = 1u << 20;
constexpr size_t WS_CTL = 0, CTL_ZERO_BYTES = 1 * MiB;
constexpr size_t WS_PARTA = 1 * MiB, WS_PARTB = 2 * MiB, WS_PGN = 3 * MiB;
constexpr size_t WS_MTOK = 5 * MiB, WS_MRS = 5 * MiB + 512 * 1024, WS_MGW = 6 * MiB, WS_MSEL = 6 * MiB + 512 * 1024, WS_WRT = 6 * MiB + 768 * 1024, WS_RSTD0 = 7 * MiB;
constexpr size_t WS_WIN = 8 * MiB, WS_WOA = 20 * MiB, WS_WGU0 = 24 * MiB, WS_WD0 = 35 * MiB, WS_WPG0 = 41 * MiB, WS_WPG1 = 43 * MiB, WS_WPU0 = 45 * MiB, WS_WPU1 = 45 * MiB + 512 * 1024,
                 WS_WQKV = 46 * MiB, WS_WOB = 52 * MiB;
constexpr size_t WS_HBX = 56 * MiB, WS_PB = 88 * MiB, WS_U = 104 * MiB;
constexpr size_t WS_Q = 136 * MiB, WS_KP = 168 * MiB, WS_KT = 200 * MiB, WS_G = 232 * MiB, WS_VT = 296 * MiB, WS_PP = 360 * MiB, WS_UT = 392 * MiB, WS_ROPE = 456 * MiB, WS_ST = 168 * MiB;
constexpr size_t WS_O = WS_UT;
constexpr size_t WS_HD = 136 * MiB, WS_HBY = 264 * MiB, WS_WGUM = 411 * MiB;
constexpr size_t WS_QB = 136 * MiB, WS_KB = 168 * MiB, WS_VBT = 200 * MiB, WS_OB = 232 * MiB;
constexpr size_t WS_HM = 136 * MiB, WS_WDM = 374 * MiB, WS_YM = 430 * MiB, WS_END = 523 * MiB;
constexpr int CW_TMO = 0, CW_CNT = 64, CW_BAR = 4096;

#define CVT_TRY(Wp, gainp, dstp, K_, N_, dld_, mode_, roff_) { const int ni_ = ((K_) / 64) * ((N_) / 32); if (r < ni_) { cvt_item((Wp), (N_), (gainp), (dstp), (dld_), (mode_), (roff_), scr, r, T.lane); continue; } r -= ni_; }

struct Ptrs {
    const float *x, *p, *norm_mix, *norm_ffn, *norm_ple, *w_in_a, *ret_gn, *w_out_a, *norm_kv, *w_kv, *w_q_b, *rel_bias, *w_out_b, *w_gate_dense, *w_up_dense, *w_down_dense,
                *w_router, *w_gate_moe, *w_up_moe, *w_down_moe, *w_ple_up, *w_ple_gate, *norm_final;
    const int* positions; float* out; unsigned char* ws;
};

__device__ __forceinline__ void t0_prologue(const TCtx& T, const Ptrs& P) {
    unsigned char* ws = P.ws;
    LAS float* scr = (LAS float*)(T.lds + T.wave * 16384);
    const int gw = T.vcu * 8 + T.wave, NGW = T.G * 8;
    constexpr int NIT = 16 * 192 + 32 * 32 + 2 * 16 * 88 + 44 * 32 + 2 * 16 * 32 + 2 * 4 * 32 + 16 * 64 + 16 * 32 + 16 * 32;
    for (int it = gw; it < NIT; it += NGW) {
        int r = it;
        CVT_TRY(P.w_in_a, P.norm_mix, (bf16_t*)(ws + WS_WIN), 1024, 6144, 1024, 0, 0)
        CVT_TRY(P.w_out_a, P.ret_gn, (bf16_t*)(ws + WS_WOA), 2048, 1024, 2048, 0, 0)
        CVT_TRY(P.w_gate_dense, P.norm_ffn, (bf16_t*)(ws + WS_WGU0), 1024, 2816, 1024, 1, 0)
        CVT_TRY(P.w_up_dense, P.norm_ffn, (bf16_t*)(ws + WS_WGU0), 1024, 2816, 1024, 1, 128)
        CVT_TRY(P.w_down_dense, (const float*)nullptr, (bf16_t*)(ws + WS_WD0), 2816, 1024, 2816, 0, 0)
        CVT_TRY(P.w_ple_gate, P.norm_ple, (bf16_t*)(ws + WS_WPG0), 1024, 1024, 1024, 0, 0)
        CVT_TRY(P.w_ple_gate + 1024 * 1024, P.norm_ple + 1024, (bf16_t*)(ws + WS_WPG1), 1024, 1024, 1024, 0, 0)
        CVT_TRY(P.w_ple_up, (const float*)nullptr, (bf16_t*)(ws + WS_WPU0), 256, 1024, 256, 0, 0)
        CVT_TRY(P.w_ple_up + 256 * 1024, (const float*)nullptr, (bf16_t*)(ws + WS_WPU1), 256, 1024, 256, 0, 0)
        CVT_TRY(P.w_q_b, P.norm_mix + 1024, (bf16_t*)(ws + WS_WQKV), 1024, 1024, 1024, 0, 0)
        CVT_TRY(P.w_kv, P.norm_kv, (bf16_t*)(ws + WS_WQKV), 1024, 2048, 1024, 0, 1024)
        CVT_TRY(P.w_out_b, (const float*)nullptr, (bf16_t*)(ws + WS_WOB), 1024, 1024, 1024, 0, 0)
    }
    {
        bf16_t* hb = (bf16_t*)(ws + WS_HBX); float* rstd0 = (float*)(ws + WS_RSTD0);
        for (int m = gw; m < M; m += NGW) {
            const f32x4* xr = (const f32x4*)(P.x + (size_t)m * D) + T.lane; f32x4 v[4]; float s = 0.f;
#pragma unroll
            for (int j = 0; j < 4; ++j) { v[j] = xr[64 * j]; s += (v[j][0] * v[j][0] + v[j][1] * v[j][1]) + (v[j][2] * v[j][2] + v[j][3] * v[j][3]); }
            s = wave_sum(s);
            if (T.lane == 0) rstd0[m] = frsq(s * (1.f / 1024.f) + EPS);
            u32x2* o = (u32x2*)(hb + (size_t)m * D) + T.lane;
#pragma unroll
            for (int j = 0; j < 4; ++j) { u32x2 w; w.x = cvt_pk_bf16(v[j][0], v[j][1]); w.y = cvt_pk_bf16(v[j][2], v[j][3]); o[64 * j] = w; }
        }
    }
    const int gt = T.vcu * 512 + T.tid, NGT = T.G * 512;
    {
        bf16_t* pb = (bf16_t*)(ws + WS_PB);
        for (int i = gt; i < 2 * M * 256 / 8; i += NGT) { const f32x4 a = ((const f32x4*)P.p)[2 * i], b = ((const f32x4*)P.p)[2 * i + 1];
            u32x4 w; w.x = cvt_pk_bf16(a[0], a[1]); w.y = cvt_pk_bf16(a[2], a[3]); w.z = cvt_pk_bf16(b[0], b[1]); w.w = cvt_pk_bf16(b[2], b[3]); ((u32x4*)pb)[i] = w; }
    }
    {
        float* wrt = (float*)(ws + WS_WRT);
        for (int i = gt; i < 8192; i += NGT) { const int e = i >> 10, k = i & 1023; wrt[i] = P.w_router[k * 8 + e] * P.norm_ffn[1024 + k]; }
    }
    {
        LAS float* invf = (LAS float*)(T.lds + 12288);
        __syncthreads();
        if (T.tid < 128) { const float ex = (float)T.tid / 127.0f; invf[T.tid] = (float)(1.0 / pow(10000.0, (double)ex)); }
        __syncthreads();
        f32x2* rope = (f32x2*)(ws + WS_ROPE);
        for (int i = gt; i < M * 128; i += NGT) { const int tok = i >> 7, k = i & 127;
            const float ang = (float)P.positions[tok] * invf[k]; double t = (double)ang * 0.15915494309189535; t -= rint(t);
            float sn, cs; sincospif(2.0f * (float)t, &sn, &cs); rope[i] = (f32x2){cs, sn}; }
    }
}
__device__ __forceinline__ void pm1_convert(const TCtx& T, const Ptrs& P) {
    LAS float* scr = (LAS float*)(T.lds + T.wave * 16384);
    const int gw = T.vcu * 8 + T.wave, NGW = T.G * 8;
    for (int it = gw; it < 8 * 3584; it += NGW) {
        const int e = it / 3584, q = it % 3584, which = q / 1792, item = q % 1792;
        cvt_item((which ? P.w_up_moe : P.w_gate_moe) + (size_t)e * 1024 * 3584, 3584, P.norm_ffn + 1024, (bf16_t*)(P.ws + WS_WGUM) + (size_t)e * 7168 * 1024, 1024, 1, which * 128, scr, item, T.lane);
    }
}
__device__ __forceinline__ void pm2_convert(const TCtx& T, const Ptrs& P) {
    LAS float* scr = (LAS float*)(T.lds + T.wave * 16384);
    const int gw = T.vcu * 8 + T.wave, NGW = T.G * 8;
    for (int it = gw; it < 8 * 1792; it += NGW) {
        const int e = it / 1792, item = it % 1792;
        cvt_item(P.w_down_moe + (size_t)e * 3584 * 1024, 1024, (const float*)nullptr, (bf16_t*)(P.ws + WS_WDM) + (size_t)e * 1024 * 3584, 3584, 0, 0, scr, item, T.lane);
    }
}
__device__ __forceinline__ void t_scan(const TCtx& T, const Ptrs& P) {
    const bf16_t* UT = (const bf16_t*)(P.ws + WS_UT); bf16_t* ST = (bf16_t*)(P.ws + WS_ST);
    for (int g = T.vcu * 512 + T.tid; g < 2048 * 64; g += T.G * 512) {
        const int vrow = g >> 6, b = (g >> 5) & 1, d8 = g & 31;
        const float g256 = fexp2(256.0f * lg2gamma(vrow >> 9));
        float s[8];
#pragma unroll
        for (int k = 0; k < 8; ++k) s[k] = 0.f;
        const size_t base = (size_t)vrow * M + (size_t)b * SEQ + d8 * 8;
        for (int j = 0; j < 32; ++j) {
            const u32x4 uu = *(const u32x4*)(UT + base + j * 256);
            *(u32x4*)(ST + base + j * 256) = pack8(s);
            s[0] = g256 * (s[0] + bf_lo(uu.x)); s[1] = g256 * (s[1] + bf_hi(uu.x)); s[2] = g256 * (s[2] + bf_lo(uu.y)); s[3] = g256 * (s[3] + bf_hi(uu.y));
            s[4] = g256 * (s[4] + bf_lo(uu.z)); s[5] = g256 * (s[5] + bf_hi(uu.z)); s[6] = g256 * (s[6] + bf_lo(uu.w)); s[7] = g256 * (s[7] + bf_hi(uu.w));
        }
    }
}
__device__ __forceinline__ void t_gn(const TCtx& T, const Ptrs& P) {
    bf16_t* O = (bf16_t*)(P.ws + WS_O); const bf16_t* Gt = (const bf16_t*)(P.ws + WS_G); const float* pgn = (const float*)(P.ws + WS_PGN);
    for (int tok = T.vcu * 8 + T.wave; tok < M; tok += T.G * 8) {
#pragma unroll
        for (int k = 0; k < 4; ++k) {
            const f32x4* pp = (const f32x4*)(pgn + (size_t)tok * 32 + k * 8); const f32x4 a = pp[0], b = pp[1];
            const float rs = frsq((((a[0] + a[1]) + (a[2] + a[3])) + ((b[0] + b[1]) + (b[2] + b[3]))) * (1.f / 512.f) + EPS);
            const size_t off = (size_t)tok * 2048 + k * 512 + T.lane * 8;
            const u32x4 ov = *(const u32x4*)(O + off), gv = *(const u32x4*)(Gt + off); float o[8];
            o[0] = bf_lo(ov.x) * bf_lo(gv.x) * rs; o[1] = bf_hi(ov.x) * bf_hi(gv.x) * rs; o[2] = bf_lo(ov.y) * bf_lo(gv.y) * rs; o[3] = bf_hi(ov.y) * bf_hi(gv.y) * rs;
            o[4] = bf_lo(ov.z) * bf_lo(gv.z) * rs; o[5] = bf_hi(ov.z) * bf_hi(gv.z) * rs; o[6] = bf_lo(ov.w) * bf_lo(gv.w) * rs; o[7] = bf_hi(ov.w) * bf_hi(gv.w) * rs;
            *(u32x4*)(O + off) = pack8(o);
        }
    }
}
__device__ __forceinline__ void t_router(const TCtx& T, const Ptrs& P) {
    LAS float* wl = (LAS float*)T.lds;
    LAS int* se = (LAS int*)(T.lds + 32768);
    LAS float* sw = (LAS float*)(T.lds + 32768 + 512);
    const float* wrt = (const float*)(P.ws + WS_WRT);
    __syncthreads();
    for (int i = T.tid; i < 8192; i += 512) wl[i] = wrt[i];
    __syncthreads();
    unsigned* cnt = (unsigned*)(P.ws + WS_CTL) + CW_CNT;
    int* mtok = (int*)(P.ws + WS_MTOK); float* mrs = (float*)(P.ws + WS_MRS); float* mgw = (float*)(P.ws + WS_MGW); int* msel = (int*)(P.ws + WS_MSEL);
    for (int tb = T.vcu; tb < M / 64; tb += T.G) {
        for (int j = 0; j < 8; ++j) {
            const int lt = T.wave * 8 + j, tok = tb * 64 + lt;
            const f32x4* hr = (const f32x4*)(P.out + (size_t)tok * D) + T.lane; f32x4 v[4]; float ss = 0.f; float lg[8];
#pragma unroll
            for (int q = 0; q < 4; ++q) { v[q] = hr[64 * q]; ss += (v[q][0] * v[q][0] + v[q][1] * v[q][1]) + (v[q][2] * v[q][2] + v[q][3] * v[q][3]); }
#pragma unroll
            for (int e = 0; e < 8; ++e) { float a = 0.f;
#pragma unroll
                for (int q = 0; q < 4; ++q) { const f32x4 w = *(const LAS f32x4*)(wl + e * 1024 + 4 * (T.lane + 64 * q)); a += (v[q][0] * w[0] + v[q][1] * w[1]) + (v[q][2] * w[2] + v[q][3] * w[3]); }
                lg[e] = wave_sum(a); }
            ss = wave_sum(ss);
            if (T.lane == 0) {
                const float rs = frsq(ss * (1.f / 1024.f) + EPS);
                int e1 = 0; float v1 = lg[0];
#pragma unroll
                for (int e = 1; e < 8; ++e) if (lg[e] > v1) { v1 = lg[e]; e1 = e; }
                int e2 = 0; float v2 = -INFINITY;
#pragma unroll
                for (int e = 0; e < 8; ++e) if (e != e1 && lg[e] > v2) { v2 = lg[e]; e2 = e; }
                const float p2 = __expf((v2 - v1) * rs), w1 = 1.f / (1.f + p2), w2 = p2 / (1.f + p2);
                se[lt * 2] = e1; se[lt * 2 + 1] = e2; sw[lt * 3] = w1; sw[lt * 3 + 1] = w2; sw[lt * 3 + 2] = rs;
            }
        }
        __syncthreads();
        if (T.wave == 0) {
            const int e1 = se[T.lane * 2], e2 = se[T.lane * 2 + 1]; int r1 = 0, r2 = 0;
            const unsigned long long ltm = (1ull << T.lane) - 1ull;
#pragma unroll
            for (int e = 0; e < 8; ++e) {
                const unsigned long long m1 = __ballot(e1 == e), m2 = __ballot(e2 == e);
                const int n1 = __popcll(m1), n = n1 + __popcll(m2);
                unsigned base = 0u;
                if (T.lane == 0 && n > 0) base = __hip_atomic_fetch_add(cnt + e, (unsigned)n, RLX_AGENT);
                base = (unsigned)__builtin_amdgcn_readfirstlane((int)base);
                if (e1 == e) r1 = (int)base + __popcll(m1 & ltm);
                if (e2 == e) r2 = (int)base + n1 + __popcll(m2 & ltm);
            }
            const int tok = tb * 64 + T.lane; const float w1 = sw[T.lane * 3], w2 = sw[T.lane * 3 + 1], rs = sw[T.lane * 3 + 2];
            mtok[e1 * 16384 + r1] = tok; mrs[e1 * 16384 + r1] = rs; mgw[e1 * 16384 + r1] = w1;
            mtok[e2 * 16384 + r2] = tok; mrs[e2 * 16384 + r2] = rs; mgw[e2 * 16384 + r2] = w2;
            *(int4*)(msel + tok * 4) = make_int4(e1, r1, e2, r2);
        }
        __syncthreads();
    }
}
__device__ __forceinline__ void t_combine(const TCtx& T, const Ptrs& P, bf16_t* hb, float* pout) {
    const unsigned* cnt = (const unsigned*)(P.ws + WS_CTL) + CW_CNT; const int* msel = (const int*)(P.ws + WS_MSEL); const bf16_t* Y = (const bf16_t*)(P.ws + WS_YM);
    int tp[8]; { int t = 0;
#pragma unroll
        for (int e = 0; e < 8; ++e) { tp[e] = t; t += ((int)cnt[e] + 255) >> 8; } }
    for (int tok = T.vcu * 8 + T.wave; tok < M; tok += T.G * 8) {
        const int4 s4 = *(const int4*)(msel + tok * 4); int b1 = 0, b2 = 0;
#pragma unroll
        for (int e = 0; e < 8; ++e) { if (s4.x == e) b1 = tp[e]; if (s4.z == e) b2 = tp[e]; }
        const size_t s1 = (size_t)(b1 * 256 + s4.y), s2 = (size_t)(b2 * 256 + s4.w); float ss = 0.f;
#pragma unroll
        for (int q = 0; q < 2; ++q) {
            const int c0 = (T.lane + 64 * q) * 8; float* hp = P.out + (size_t)tok * D + c0;
            f32x4 a = *(const f32x4*)hp, b = *(const f32x4*)(hp + 4); const u32x4 y1 = *(const u32x4*)(Y + s1 * 1024 + c0), y2 = *(const u32x4*)(Y + s2 * 1024 + c0);
            a[0] += bf_lo(y1.x) + bf_lo(y2.x); a[1] += bf_hi(y1.x) + bf_hi(y2.x); a[2] += bf_lo(y1.y) + bf_lo(y2.y); a[3] += bf_hi(y1.y) + bf_hi(y2.y);
            b[0] += bf_lo(y1.z) + bf_lo(y2.z); b[1] += bf_hi(y1.z) + bf_hi(y2.z); b[2] += bf_lo(y1.w) + bf_lo(y2.w); b[3] += bf_hi(y1.w) + bf_hi(y2.w);
            *(f32x4*)hp = a; *(f32x4*)(hp + 4) = b;
            ss += ((a[0] * a[0] + a[1] * a[1]) + (a[2] * a[2] + a[3] * a[3])) + ((b[0] * b[0] + b[1] * b[1]) + (b[2] * b[2] + b[3] * b[3]));
            u32x4 w; w.x = cvt_pk_bf16(a[0], a[1]); w.y = cvt_pk_bf16(a[2], a[3]); w.z = cvt_pk_bf16(b[0], b[1]); w.w = cvt_pk_bf16(b[2], b[3]); *(u32x4*)(hb + (size_t)tok * D + c0) = w;
        }
        ss = wave_sum(ss);
        if (T.lane < 16) pout[(size_t)tok * 16 + T.lane] = T.lane == 0 ? ss : 0.f;
    }
}
__device__ __forceinline__ void t_final(const TCtx& T, const Ptrs& P, const float* pin) {
    for (int tok = T.vcu * 8 + T.wave; tok < M; tok += T.G * 8) {
        const float rs = rstd16(pin, tok); f32x4* hr = (f32x4*)(P.out + (size_t)tok * D) + T.lane; const f32x4* gg = (const f32x4*)P.norm_final + T.lane;
#pragma unroll
        for (int q = 0; q < 4; ++q) { f32x4 v = hr[64 * q]; const f32x4 g = gg[64 * q]; v = v * rs; v = v * g; hr[64 * q] = v; }
    }
}

__device__ __forceinline__ int crow(int r, int hi) { return (r & 3) + 8 * (r >> 2) + 4 * hi; }
__device__ __forceinline__ void attn_phase(const TCtx& T, const Ptrs& P) {
    const bf16_t* Qb = (const bf16_t*)(P.ws + WS_QB); const bf16_t* Kb = (const bf16_t*)(P.ws + WS_KB); const bf16_t* VbT = (const bf16_t*)(P.ws + WS_VBT); bf16_t* Ob = (bf16_t*)(P.ws + WS_OB);
    LAS float* tab = (LAS float*)T.lds;
    __syncthreads();
    for (int i = T.tid; i < 16 * 320; i += 512) tab[i] = P.rel_bias[i] * LOG2E;
    __syncthreads();
    const int l = T.lane & 31, hi = T.lane >> 5;
    for (int g = T.vcu; g < 1024; g += T.G) {
        const int b = g >> 9, c = (g >> 2) & 127, h = (g & 3) * 4 + (T.wave >> 1), half = T.wave & 1;
        const int tokq = b * SEQ + c * 64 + half * 32 + l;
        bf16x8 qr[4];
#pragma unroll
        for (int d0 = 0; d0 < 4; ++d0) qr[d0] = *(const bf16x8*)(Qb + (size_t)tokq * D + h * 64 + 16 * d0 + 8 * hi);
        f32x16 o0 = {}, o1 = {}; float mrun = -1e30f, lsum = 0.f;
        const LAS float* tb = tab + h * 320;
        const int iq = half * 32 + l;
        for (int jt = (c < 8 ? 8 - c : 0); jt < 9; ++jt) {
            const int tokk = b * SEQ + (c - 8 + jt) * 64;
            f32x16 s0 = {}, s1 = {};
#pragma unroll
            for (int d0 = 0; d0 < 4; ++d0) {
                const bf16x8 k0 = *(const bf16x8*)(Kb + (size_t)(tokk + l) * D + h * 64 + 16 * d0 + 8 * hi);
                const bf16x8 k1 = *(const bf16x8*)(Kb + (size_t)(tokk + 32 + l) * D + h * 64 + 16 * d0 + 8 * hi);
                s0 = __builtin_amdgcn_mfma_f32_32x32x16_bf16(k0, qr[d0], s0, 0, 0, 0);
                s1 = __builtin_amdgcn_mfma_f32_32x32x16_bf16(k1, qr[d0], s1, 0, 0, 0);
            }
            if (jt <= 3) { const float bc = tb[319];
#pragma unroll
                for (int r = 0; r < 16; ++r) { s0[r] += bc; s1[r] += bc; }
            } else {
                const int dbase = iq + 64 * (8 - jt) + 63;
#pragma unroll
                for (int r = 0; r < 16; ++r) { const int kr = crow(r, hi); int i0 = dbase - kr, i1 = dbase - kr - 32; i0 = i0 > 319 ? 319 : i0; i1 = i1 > 319 ? 319 : i1; s0[r] += tb[i0]; s1[r] += tb[i1]; }
            }
            float mx = s0[0];
#pragma unroll
            for (int r = 1; r < 16; ++r) mx = fmaxf(mx, s0[r]);
#pragma unroll
            for (int r = 0; r < 16; ++r) mx = fmaxf(mx, s1[r]);
            mx = fmaxf(mx, __shfl_xor(mx, 32));
            const float mnew = fmaxf(mrun, mx), f = fexp2(mrun - mnew); mrun = mnew;
            float ps = 0.f;
#pragma unroll
            for (int r = 0; r < 16; ++r) { s0[r] = fexp2(s0[r] - mnew); s1[r] = fexp2(s1[r] - mnew); ps += s0[r] + s1[r]; }
            lsum = lsum * f + ps;
#pragma unroll
            for (int r = 0; r < 16; ++r) { o0[r] *= f; o1[r] *= f; }
#pragma unroll
            for (int ks = 0; ks < 4; ++ks) {
                u32x4 pw;
                if (ks < 2) { pw.x = cvt_pk_bf16(s0[8 * ks + 0], s0[8 * ks + 1]); pw.y = cvt_pk_bf16(s0[8 * ks + 2], s0[8 * ks + 3]); pw.z = cvt_pk_bf16(s0[8 * ks + 4], s0[8 * ks + 5]); pw.w = cvt_pk_bf16(s0[8 * ks + 6], s0[8 * ks + 7]); }
                else { const int k2 = ks - 2; pw.x = cvt_pk_bf16(s1[8 * k2 + 0], s1[8 * k2 + 1]); pw.y = cvt_pk_bf16(s1[8 * k2 + 2], s1[8 * k2 + 3]); pw.z = cvt_pk_bf16(s1[8 * k2 + 4], s1[8 * k2 + 5]); pw.w = cvt_pk_bf16(s1[8 * k2 + 6], s1[8 * k2 + 7]); }
                const bf16x8 pf = __builtin_bit_cast(bf16x8, pw);
#pragma unroll
                for (int db = 0; db < 2; ++db) {
                    const bf16_t* vp = VbT + (size_t)(h * 64 + 32 * db + l) * M + tokk + 16 * ks + 4 * hi;
                    const u32x2 va = *(const u32x2*)vp, vb = *(const u32x2*)(vp + 8);
                    const u32x4 vw = {va.x, va.y, vb.x, vb.y};
                    if (db == 0) o0 = __builtin_amdgcn_mfma_f32_32x32x16_bf16(__builtin_bit_cast(bf16x8, vw), pf, o0, 0, 0, 0);
                    else o1 = __builtin_amdgcn_mfma_f32_32x32x16_bf16(__builtin_bit_cast(bf16x8, vw), pf, o1, 0, 0, 0);
                }
            }
        }
        lsum += __shfl_xor(lsum, 32);
        const float inv = frcp(lsum);
        bf16_t* op = Ob + (size_t)tokq * D + h * 64 + 4 * hi;
#pragma unroll
        for (int g4 = 0; g4 < 4; ++g4) {
            u32x2 w0, w1; w0.x = cvt_pk_bf16(o0[4 * g4] * inv, o0[4 * g4 + 1] * inv); w0.y = cvt_pk_bf16(o0[4 * g4 + 2] * inv, o0[4 * g4 + 3] * inv);
            w1.x = cvt_pk_bf16(o1[4 * g4] * inv, o1[4 * g4 + 1] * inv); w1.y = cvt_pk_bf16(o1[4 * g4 + 2] * inv, o1[4 * g4 + 3] * inv);
            *(u32x2*)(op + 8 * g4) = w0; *(u32x2*)(op + 32 + 8 * g4) = w1;
        }
    }
}
#define XB_TMO      128
#define XB_XCNT(j)  (256  + 64 * (j))
#define XB_XSUB(j)  (1280 + 64 * (j))
#define XB_XGEN(j)  (2304 + 64 * (j))
#define XB_TOP      3328
#define XB_TOPGEN   3392
#define XCD_BAR_WORDS 3456
#define XB_SPIN_CAP (1u << 18)

__device__ __forceinline__ unsigned xb_ld(unsigned* p)              { return __hip_atomic_load(p, __ATOMIC_RELAXED, __HIP_MEMORY_SCOPE_AGENT); }
__device__ __forceinline__ unsigned xb_add(unsigned* p, unsigned v) { return __hip_atomic_fetch_add(p, v, __ATOMIC_RELAXED, __HIP_MEMORY_SCOPE_AGENT); }
__device__ __forceinline__ unsigned xb_xcc_id() { return (unsigned)__builtin_amdgcn_s_getreg((3 << 11) | 20) & 0xFu; }
#define XB_SPIN(cond, bar) do { unsigned _sp = 0; while (cond) { __builtin_amdgcn_s_sleep(1); \
    if ((++_sp & 255u) == 0u) { if (xb_ld(&(bar)[XB_TMO])) break; if (_sp > XB_SPIN_CAP) { atomicAdd(&(bar)[XB_TMO], 1u); break; } } } } while (0)

struct XcdBarrier {
    unsigned* bar; unsigned x;
    volatile LAS unsigned* st;
};

__device__ __forceinline__ XcdBarrier xcd_barrier_post(unsigned* bar, volatile LAS unsigned* st) {
    XcdBarrier b; b.bar = bar; b.x = xb_xcc_id(); b.st = st;
    if (threadIdx.x == 0) (void)xb_add(&bar[XB_XCNT(b.x)], 1u);
    return b;
}
__device__ __forceinline__ void xcd_barrier_complete(unsigned* bar, unsigned x, unsigned& nloc, unsigned& nx) {
    const unsigned G = gridDim.x * gridDim.y * gridDim.z;
    unsigned sum, cnt, mine, sp = 0u;
    for (;;) {
        sum = 0u; cnt = 0u; mine = 0u;
#pragma unroll
        for (unsigned j = 0; j < 16; ++j) { const unsigned c = xb_ld(&bar[XB_XCNT(j)]); sum += c; cnt += (c > 0u) ? 1u : 0u; mine = (j == x) ? c : mine; }
        if (sum == G) break;
        __builtin_amdgcn_s_sleep(1);
        if ((++sp & 255u) == 0u) { if (xb_ld(&bar[XB_TMO])) break; if (sp > XB_SPIN_CAP) { atomicAdd(&bar[XB_TMO], 1u); break; } }
    }
    nloc = mine > 0u ? mine : 1u; nx = cnt > 0u ? cnt : 1u;
}

__device__ __forceinline__ void xcd_barrier(const XcdBarrier& b) {
    asm volatile("s_waitcnt vmcnt(0)" ::: "memory");
    __syncthreads();
    if (threadIdx.x == 0) {
        unsigned* bar = b.bar;
        __builtin_amdgcn_s_waitcnt(0);
        unsigned nloc = b.st[0], nx = b.st[1];
        if (nloc == 0u) { xcd_barrier_complete(bar, b.x, nloc, nx); b.st[0] = nloc; b.st[1] = nx; }
        const unsigned old = xb_add(&bar[XB_XSUB(b.x)], 1u);
        const unsigned gen = old / nloc;
        if (old + 1u == (gen + 1u) * nloc) {
            __builtin_amdgcn_fence(__ATOMIC_RELEASE, "agent");
            asm volatile("s_waitcnt vmcnt(0)" ::: "memory");
            const unsigned og = xb_add(&bar[XB_TOP], 1u);
            const unsigned tg = og / nx;
            if (og + 1u == (tg + 1u) * nx) xb_add(&bar[XB_TOPGEN], 1u);
            else XB_SPIN(xb_ld(&bar[XB_TOPGEN]) == tg, bar);
            __builtin_amdgcn_fence(__ATOMIC_ACQUIRE, "agent");
            xb_add(&bar[XB_XGEN(b.x)], 1u);
            asm volatile("s_waitcnt vmcnt(0)" ::: "memory");
        } else {
            XB_SPIN(xb_ld(&bar[XB_XGEN(b.x)]) == gen, bar);
            __builtin_amdgcn_fence(__ATOMIC_ACQUIRE, "agent");
            asm volatile("s_waitcnt vmcnt(0)" ::: "memory");
        }
    }
    __syncthreads();
}

constexpr int LDS_RING = 131072, LDS_MISC = LDS_RING, LDS_BYTES = 147456;
constexpr int NPH = 21;
struct Args { const void* in[24]; float* out; unsigned char* ws; int ph_lo, ph_hi, use_bar, pad; };

__global__ void __launch_bounds__(512, 2) fwd(Args a) {
    extern __shared__ __attribute__((aligned(16))) unsigned char lds_raw[];
    LAS unsigned char* lds = (LAS unsigned char*)lds_raw;
    TCtx T; T.lds = lds; T.tid = threadIdx.x; T.lane = T.tid & 63; T.wave = __builtin_amdgcn_readfirstlane(T.tid >> 6); T.G = gridDim.x;
    { const int bx = blockIdx.x; T.vcu = (T.G % 8 == 0) ? (bx % 8) * (T.G / 8) + bx / 8 : bx; }
    typedef const Args __attribute__((address_space(4))) CArgs;
    CArgs* ap = (CArgs*)__builtin_amdgcn_kernarg_segment_ptr();
#define LOAD_P() Ptrs P; { asm volatile("" : "+s"(ap)); \
    P.x = (const float*)ap->in[0]; P.p = (const float*)ap->in[1]; P.positions = (const int*)ap->in[2]; P.norm_mix = (const float*)ap->in[3]; P.norm_ffn = (const float*)ap->in[4]; P.norm_ple = (const float*)ap->in[5]; \
    P.w_in_a = (const float*)ap->in[6]; P.ret_gn = (const float*)ap->in[7]; P.w_out_a = (const float*)ap->in[8]; P.norm_kv = (const float*)ap->in[9]; P.w_kv = (const float*)ap->in[10]; P.w_q_b = (const float*)ap->in[11]; \
    P.rel_bias = (const float*)ap->in[12]; P.w_out_b = (const float*)ap->in[13]; P.w_gate_dense = (const float*)ap->in[14]; P.w_up_dense = (const float*)ap->in[15]; P.w_down_dense = (const float*)ap->in[16]; \
    P.w_router = (const float*)ap->in[17]; P.w_gate_moe = (const float*)ap->in[18]; P.w_up_moe = (const float*)ap->in[19]; P.w_down_moe = (const float*)ap->in[20]; P.w_ple_up = (const float*)ap->in[21]; \
    P.w_ple_gate = (const float*)ap->in[22]; P.norm_final = (const float*)ap->in[23]; P.out = ap->out; P.ws = ap->ws; }
    unsigned char* ws = a.ws;
    volatile LAS unsigned* MISC = (volatile LAS unsigned*)(lds + LDS_MISC);
    if (T.tid < 64) ((LAS unsigned*)(lds + LDS_MISC))[T.tid] = 0u;
    __syncthreads();
    XcdBarrier bar; bar.bar = (unsigned*)(ws + WS_CTL) + CW_BAR; bar.x = 0; bar.st = nullptr;
    if (a.use_bar) bar = xcd_barrier_post((unsigned*)(ws + WS_CTL) + CW_BAR, MISC + 8);
    const int lo = a.ph_lo, hi = a.ph_hi, G = T.G, c = (int)blockIdx.x;
#ifndef PH_MASK
#define PH_MASK 0x1fffff
#endif
#define IN(k) ((((PH_MASK) >> (k)) & 1) && lo <= (k) && (k) < hi)
#define SEAM(k) do { if (IN((k) + 1)) xcd_barrier(bar); } while (0)
    bf16_t* hbX = (bf16_t*)(ws + WS_HBX); bf16_t* hbY = (bf16_t*)(ws + WS_HBY);
    float* partA = (float*)(ws + WS_PARTA); float* partB = (float*)(ws + WS_PARTB);

    if (IN(0)) { LOAD_P(); t0_prologue(T, P); SEAM(0); }
    if (IN(1)) { LOAD_P(); (void)P;
        SchedINA S{G, c, (const char*)hbX, (const char*)(ws + WS_WIN)};
        EpiINA E{(const float*)(ws + WS_RSTD0), (const f32x2*)(ws + WS_ROPE), (bf16_t*)(ws + WS_Q), (bf16_t*)(ws + WS_KP), (bf16_t*)(ws + WS_G), (bf16_t*)(ws + WS_KT), (bf16_t*)(ws + WS_VT)};
        gemm_phase<EpiINA, SchedINA, false, false>(lds, 1024, 1024, 16, 16, S, E);
        SEAM(1);
    }
    if (IN(2)) { LOAD_P(); (void)P;
#ifndef P2SEL
#define P2SEL 7
#endif
        if (P2SEL & 1) { SchedGen S{G, c, 64, 4, (const char*)(ws + WS_Q), (const char*)(ws + WS_KP), nullptr, nullptr, 524288, 512, 524288, 512, 0, 0};
          EpiStore E{(bf16_t*)(ws + WS_PP), 1024, 1};
          gemm_phase<EpiStore, SchedGen, false, false>(lds, 1024, 1024, 4, 4, S, E); }
        if (P2SEL & 2) { SchedGen S{G, c, 8, 64, (const char*)(ws + WS_VT), (const char*)(ws + WS_KT), nullptr, nullptr, 8388608, 512, 8388608, 512, 0, 1};
          EpiStore E{(bf16_t*)(ws + WS_UT), 16384, 0};
          gemm_phase<EpiStore, SchedGen, false, false>(lds, 16384, 16384, 4, 4, S, E); }
        if (P2SEL & 4) { SchedGen S{G, c, 64, 4, (const char*)(ws + WS_PB), (const char*)(ws + WS_WPU0), nullptr, nullptr, 131072, 0, 0, 131072, 0, 0};
          EpiStore E{(bf16_t*)(ws + WS_U), 1024, 0};
          gemm_phase<EpiStore, SchedGen, false, false>(lds, 256, 256, 4, 4, S, E); }
        SEAM(2);
    }
    if (IN(3)) { LOAD_P(); t_scan(T, P); SEAM(3); }
    if (IN(4)) { LOAD_P(); (void)P;
        SchedGen S{G, c, 64, 8, (const char*)(ws + WS_PP), (const char*)(ws + WS_VT), (const char*)(ws + WS_Q), (const char*)(ws + WS_ST), 524288, 512, 512, 8388608, 1, 0};
        EpiR3 E{(bf16_t*)(ws + WS_O), (float*)(ws + WS_PGN)};
        gemm_phase<EpiR3, SchedGen, true, false>(lds, 1024, 16384, 8, 4, S, E);
        SEAM(4);
    }
    if (IN(5)) { LOAD_P(); t_gn(T, P); SEAM(5); }
    if (IN(6)) { LOAD_P(); (void)P;
        SchedGen S{G, c, 64, 4, (const char*)(ws + WS_O), (const char*)(ws + WS_WOA), nullptr, nullptr, 1048576, 0, 0, 1048576, 0, 0};
        EpiRes<0> E{P.x, P.out, hbX, partB, nullptr, nullptr};
        gemm_phase<EpiRes<0>, SchedGen, false, false>(lds, 2048, 2048, 32, 32, S, E);
        SEAM(6);
    }
    if (IN(7)) { LOAD_P(); pm1_convert(T, P); SEAM(7); }
    if (IN(8)) { LOAD_P(); (void)P;
        SchedGen S{G, c, 64, 22, (const char*)hbX, (const char*)(ws + WS_WGU0), nullptr, nullptr, 524288, 0, 0, 524288, 0, 0};
        EpiGU<false> E{(bf16_t*)(ws + WS_HD), 2816, partB, nullptr, nullptr};
        gemm_phase<EpiGU<false>, SchedGen, false, false>(lds, 1024, 1024, 16, 16, S, E);
        SEAM(8);
    }
    if (IN(9)) { LOAD_P(); (void)P;
        SchedGen S{G, c, 64, 4, (const char*)(ws + WS_HD), (const char*)(ws + WS_WD0), nullptr, nullptr, 1441792, 0, 0, 1441792, 0, 0};
        EpiRes<0> E{P.out, P.out, hbX, partA, nullptr, nullptr};
        gemm_phase<EpiRes<0>, SchedGen, false, false>(lds, 2816, 2816, 44, 44, S, E);
        SEAM(9);
    }
    if (IN(10)) { LOAD_P(); (void)P;
        SchedGen S{G, c, 64, 4, (const char*)hbX, (const char*)(ws + WS_WPG0), nullptr, nullptr, 524288, 0, 0, 524288, 0, 0};
        EpiRes<1> E{P.out, P.out, hbY, partB, partA, (const bf16_t*)(ws + WS_U)};
        gemm_phase<EpiRes<1>, SchedGen, false, false>(lds, 1024, 1024, 16, 16, S, E);
        SEAM(10);
    }
    if (IN(11)) { LOAD_P(); (void)P;
        SchedQKVB S{G, c, (const char*)hbY, (const char*)(ws + WS_WQKV)};
        EpiQKVB E{partB, (bf16_t*)(ws + WS_QB), (bf16_t*)(ws + WS_KB), (bf16_t*)(ws + WS_VBT)};
        gemm_phase<EpiQKVB, SchedQKVB, false, false>(lds, 1024, 1024, 16, 16, S, E);
        SEAM(11);
    }
    if (IN(12)) { LOAD_P(); attn_phase(T, P); SEAM(12); }
    if (IN(13)) { LOAD_P(); (void)P;
        SchedGen S{G, c, 64, 4, (const char*)(ws + WS_OB), (const char*)(ws + WS_WOB), nullptr, nullptr, 524288, 0, 0, 524288, 0, 0};
        EpiRes<0> E{P.out, P.out, hbX, partA, nullptr, nullptr};
        gemm_phase<EpiRes<0>, SchedGen, false, false>(lds, 1024, 1024, 16, 16, S, E);
        SEAM(13);
    }
    if (IN(14)) { LOAD_P(); t_router(T, P); SEAM(14); }
    if (IN(15)) { LOAD_P(); (void)P;
        SchedMoe S; S.G = G; S.c = c; S.nN = 28; S.init_counts((const unsigned*)(ws + WS_CTL) + CW_CNT);
        S.A = (const char*)hbX; S.B = (const char*)(ws + WS_WGUM); S.b_e = 14680064; S.b_pn = 524288; S.a_rt = 0; S.tok = (const int*)(ws + WS_MTOK);
        EpiGU<true> E{(bf16_t*)(ws + WS_HM), 3584, nullptr, (const float*)(ws + WS_MRS), (const float*)(ws + WS_MGW)};
        gemm_phase<EpiGU<true>, SchedMoe, false, true>(lds, 1024, 1024, 16, 16, S, E);
        SEAM(15);
    }
    if (IN(16)) { LOAD_P(); pm2_convert(T, P); SEAM(16); }
    if (IN(17)) { LOAD_P(); (void)P;
        { SchedMoe S; S.G = G; S.c = c; S.nN = 4; S.init_counts((const unsigned*)(ws + WS_CTL) + CW_CNT);
          S.A = (const char*)(ws + WS_HM); S.B = (const char*)(ws + WS_WDM); S.b_e = 7340032; S.b_pn = 1835008; S.a_rt = 1835008; S.tok = nullptr;
          EpiStore E{(bf16_t*)(ws + WS_YM), 1024, 0};
          gemm_phase<EpiStore, SchedMoe, false, false>(lds, 3584, 3584, 56, 56, S, E); }
        { SchedGen S{G, c, 64, 4, (const char*)(ws + WS_PB) + (size_t)M * 256 * 2, (const char*)(ws + WS_WPU1), nullptr, nullptr, 131072, 0, 0, 131072, 0, 0};
          EpiStore E{(bf16_t*)(ws + WS_U), 1024, 0};
          gemm_phase<EpiStore, SchedGen, false, false>(lds, 256, 256, 4, 4, S, E); }
        SEAM(17);
    }
    if (IN(18)) { LOAD_P(); t_combine(T, P, hbX, partB); SEAM(18); }
    if (IN(19)) { LOAD_P(); (void)P;
        SchedGen S{G, c, 64, 4, (const char*)hbX, (const char*)(ws + WS_WPG1), nullptr, nullptr, 524288, 0, 0, 524288, 0, 0};
        EpiRes<1> E{P.out, P.out, nullptr, partA, partB, (const bf16_t*)(ws + WS_U)};
        gemm_phase<EpiRes<1>, SchedGen, false, false>(lds, 1024, 1024, 16, 16, S, E);
        SEAM(19);
    }
    if (IN(20)) { LOAD_P(); t_final(T, P, partA); }
#undef IN
#undef SEAM
}

static int g_grid = 0;
static bool setup_once() {
    if (g_grid) return g_grid > 0;
    int dev = 0, cus = 0, per_cu = 0;
    if (hipGetDevice(&dev) != hipSuccess || hipDeviceGetAttribute(&cus, hipDeviceAttributeMultiprocessorCount, dev) != hipSuccess) { fprintf(stderr, "setup: device query failed\n"); g_grid = -1; return false; }
    if (hipFuncSetAttribute((const void*)fwd, hipFuncAttributeMaxDynamicSharedMemorySize, LDS_BYTES) != hipSuccess) { fprintf(stderr, "setup: hipFuncSetAttribute failed\n"); g_grid = -1; return false; }
    if (hipOccupancyMaxActiveBlocksPerMultiprocessor(&per_cu, (const void*)fwd, 512, LDS_BYTES) != hipSuccess || per_cu < 1) fprintf(stderr, "setup: occupancy query says %d\n", per_cu);
    (void)hipGetLastError();
    g_grid = cus;
    return true;
}
static void fill_args(Args& a, void* const* d_in, float* out, unsigned char* ws) { for (int i = 0; i < 24; ++i) a.in[i] = d_in[i]; a.out = out; a.ws = ws; a.pad = 0; }
static void launch_phases(void* const* d_in, float* out, unsigned char* ws, hipStream_t st, int lo, int hi, int use_bar) {
    Args a{}; fill_args(a, d_in, out, ws); a.ph_lo = lo; a.ph_hi = hi; a.use_bar = use_bar;
    hipLaunchKernelGGL(fwd, dim3(g_grid), dim3(512), LDS_BYTES, st, a);
}
}
#if FX_MODE == 1
namespace dbg {
constexpr int NCHK = 24;
constexpr size_t SNAP_BASE = (size_t)DBG_SNAP_MIB << 20;
struct Chk { size_t off; int cols; };
__global__ void __launch_bounds__(256) k_snap(const void* src, int is_bf16, long s_row, long s_col, int cols, float* dst) {
    const long n = (long)1024 * cols;
    for (long i = (long)blockIdx.x * 256 + threadIdx.x; i < n; i += (long)gridDim.x * 256) {
        const long sr = i / cols, c = i % cols, r = sr * 16; const long e = r * s_row + c * s_col;
        float v; if (is_bf16) v = __uint_as_float((unsigned)((const unsigned short*)src)[e] << 16); else v = ((const float*)src)[e];
        dst[i] = v;
    }
}
__global__ void __launch_bounds__(256) k_cmp(const float* snap, int cols, const float* nvp, long n_row, int b, int mode, float scale, float* err) {
    const long n = (long)512 * cols; float e0 = 0.f, e1 = 0.f;
    for (long i = (long)blockIdx.x * 256 + threadIdx.x; i < n; i += (long)gridDim.x * 256) {
        const long sr = i / cols, c = i % cols, rl = sr * 16;
        float nvv = nvp[rl * n_row + c];
        if (mode == 1) { const int h = (int)(c >> 8); const float lg = log2f(1.0f - exp2f(-5.0f - (float)h)); nvv *= exp2f(-(float)((rl & 255) + 1) * lg); }
        else if (mode == 2) nvv = nvv / (1.f + __expf(-nvv));
        else if (mode == 3) nvv *= scale;
        const float f = snap[((long)b * 512 + sr) * cols + c], d = f - nvv;
        e0 += d * d; e1 += nvv * nvv;
    }
    for (int o = 1; o < 64; o <<= 1) { e0 += __shfl_xor(e0, o); e1 += __shfl_xor(e1, o); }
    if ((threadIdx.x & 63) == 0) { atomicAdd(err, e0); atomicAdd(err + 1, e1); }
}
struct UsedArr { int u[NCHK]; };
__global__ void __launch_bounds__(256) k_finalize(float* out, const float* err, UsedArr used, long n4) {
    float sc = 1.f;
    for (int k = 0; k < NCHK; ++k) if (used.u[k]) { const float e0 = err[2 * k], e1 = err[2 * k + 1]; const bool bad = !(e0 <= DBG_THR * e1); if (bad) { sc = 1.f + 0.1f * (float)(k + 1); break; } }
    for (long i = (long)blockIdx.x * 256 + threadIdx.x; i < n4; i += (long)gridDim.x * 256) { float4 v = ((float4*)out)[i]; v.x *= sc; v.y *= sc; v.z *= sc; v.w *= sc; ((float4*)out)[i] = v; }
}
static unsigned char* g_ws = nullptr; static float* g_err = nullptr; static size_t g_cur = 0;
static size_t g_off[NCHK]; static int g_cols[NCHK]; static int g_have[NCHK];
static void snap(hipStream_t st, int k, const void* src, int is_bf16, long s_row, long s_col, int cols) {
    g_off[k] = g_cur; g_cols[k] = cols; g_have[k] = 1; g_cur += (size_t)1024 * cols * 4;
    hipLaunchKernelGGL(k_snap, dim3(2048), dim3(256), 0, st, src, is_bf16, s_row, s_col, cols, (float*)(g_ws + SNAP_BASE + g_off[k]));
}
static void cmp(hipStream_t st, int k, const float* nvp, long n_row, int b, int mode, float scale) {
    if (!g_have[k]) return;
    hipLaunchKernelGGL(k_cmp, dim3(1024), dim3(256), 0, st, (const float*)(g_ws + SNAP_BASE + g_off[k]), g_cols[k], nvp, n_row, b, mode, scale, g_err + 2 * k);
}
static void hook(int pt, int b, const float* p, hipStream_t st) {
    switch (pt) {
    case 0: cmp(st, 0, p, 6144, b, 0, 1.f); cmp(st, 1, p + 1024, 6144, b, 1, 1.f); cmp(st, 2, p + 4096, 6144, b, 2, 1.f); cmp(st, 3, p + 1024, 6144, b, 1, 1.f); cmp(st, 4, p + 2048, 6144, b, 0, 1.f); break;
    case 1: cmp(st, 5, p, 2048, b, 0, 1.f); break;
    case 2: cmp(st, 6, p, 1024, b, 0, 1.f); break;
    case 3: cmp(st, 7, p, 1024, b, 0, 1.f); break;
    case 4: cmp(st, 8, p, 1024, b, 0, 1.f); break;
    case 5: cmp(st, 9, p + (size_t)8192 * 2048, 1024, b, 3, fx::C2Q); cmp(st, 10, p, 2048, b, 0, 1.f); cmp(st, 11, p + 1024, 2048, b, 0, 1.f); break;
    case 6: cmp(st, 12, p, 1024, b, 0, 1.f); break;
    case 7: cmp(st, 13, p, 1024, b, 0, 1.f); break;
    case 8: cmp(st, 14, p, 1024, b, 0, 1.f); break;
    case 9: cmp(st, 15, p, 1024, b, 0, 1.f); break;
    case 10: cmp(st, 16, p, 1024, b, 0, 1.f); break;
    default: break;
    }
}
}
#endif

extern "C" void kernel_launch(void* const* d_in, const int* in_sizes, int n_in, void* d_out, int out_size, void* d_ws, size_t ws_size, hipStream_t stream) {
    if (n_in != 24 || out_size != 2 * 8192 * 1024 || ws_size < fx::WS_END) { fprintf(stderr, "kernel_launch: unexpected shapes (n_in %d out %d ws %zu)\n", n_in, out_size, ws_size); return; }
    float* out = (float*)d_out; unsigned char* ws = (unsigned char*)d_ws;
#if FX_MODE == 0
    nv::forward(d_in, out, ws, stream);
#else
    if (!fx::setup_once()) return;
    (void)hipMemsetAsync(ws + fx::WS_CTL, 0, fx::CTL_ZERO_BYTES, stream);
#if FX_MODE == 3
    fx::launch_phases(d_in, out, ws, stream, 0, fx::NPH, 1);
#elif FX_MODE == 2
    for (int ph = 0; ph < fx::NPH; ++ph) fx::launch_phases(d_in, out, ws, stream, ph, ph + 1, 0);
#else
    using namespace fx;
    dbg::g_ws = ws; dbg::g_cur = 0; for (int k = 0; k < dbg::NCHK; ++k) dbg::g_have[k] = 0;
    dbg::g_err = (float*)(ws + dbg::SNAP_BASE - 4096);
    for (int ph = 0; ph < DBG_HI; ++ph) {
        if (DBG_SKIP7 && ph == 7) continue;
        launch_phases(d_in, out, ws, stream, ph, ph + 1, 0);
        if (DBG_SET == 0) {
            if (ph == 1) { dbg::snap(stream, 0, ws + WS_Q, 1, 1024, 1, 1024); dbg::snap(stream, 1, ws + WS_KP, 1, 1024, 1, 1024); dbg::snap(stream, 2, ws + WS_G, 1, 2048, 1, 2048);
                           dbg::snap(stream, 3, ws + WS_KT, 1, 1, 16384, 1024); dbg::snap(stream, 4, ws + WS_VT, 1, 1, 16384, 2048); }
            if (ph == 4) dbg::snap(stream, 5, ws + WS_O, 1, 2048, 1, 2048);
            if (ph == 6) dbg::snap(stream, 6, out, 0, 1024, 1, 1024);
        }
        if (DBG_SET == 2) {
            if (ph == 18) dbg::snap(stream, 14, out, 0, 1024, 1, 1024);
            if (ph == 19) dbg::snap(stream, 15, out, 0, 1024, 1, 1024);
            if (ph == 20) dbg::snap(stream, 16, out, 0, 1024, 1, 1024);
        }
        if (DBG_SET == 1) {
            if (ph == 6) dbg::snap(stream, 6, out, 0, 1024, 1, 1024);
            if (ph == 9) dbg::snap(stream, 7, out, 0, 1024, 1, 1024);
            if (ph == 10) dbg::snap(stream, 8, out, 0, 1024, 1, 1024);
            if (ph == 11) { dbg::snap(stream, 9, ws + WS_QB, 1, 1024, 1, 1024); dbg::snap(stream, 10, ws + WS_KB, 1, 1024, 1, 1024); dbg::snap(stream, 11, ws + WS_VBT, 1, 1, 16384, 1024); }
            if (ph == 12) dbg::snap(stream, 12, ws + WS_OB, 1, 1024, 1, 1024);
            if (ph == 13) dbg::snap(stream, 13, out, 0, 1024, 1, 1024);
        }
    }
    dbg::UsedArr used{}; for (int k = 0; k < dbg::NCHK; ++k) used.u[k] = dbg::g_have[k];
    (void)hipMemsetAsync(ws + dbg::SNAP_BASE - 4096, 0, 4096, stream);
    nv::g_hook = dbg::hook;
    nv::forward(d_in, out, ws, stream);
    hipLaunchKernelGGL(dbg::k_finalize, dim3(2048), dim3(256), 0, stream, out, (const float*)dbg::g_err, used, (long)2 * 8192 * 1024 / 4);
#endif
#endif
}
```

```cpp
#include <hip/hip_runtime.h>
#include <cstdio>
#include <cstdint>
#ifndef FX_MODE
#define FX_MODE 3
#endif
#define DUP_MASK 0

#define DBG_HI 20
#define DBG_SET 2
#define DBG_SKIP7 0
#define DBG_SNAP_MIB 380
#define DBG_THR 4e-4f
namespace nv {
static void (*g_hook)(int, int, const float*, hipStream_t) = nullptr;
#define NV_HOOK(pt, ptr) do { if (g_hook) g_hook((pt), b, (const float*)(ptr), st); } while (0)
constexpr int S = 8192, D = 1024, NB = 2;
constexpr int RQK = 1024, RV = 2048, DFF = 2816, NE = 8, DFE = 3584, PLE = 256;
constexpr float EPS = 1e-6f;

__device__ __forceinline__ float wave_sum(float v) {
#pragma unroll
    for (int o = 1; o < 64; o <<= 1) v += __shfl_xor(v, o);
    return v;
}
__device__ __forceinline__ float silu_f(float x) { return x / (1.f + __expf(-x)); }
__device__ __forceinline__ float sigmoid_f(float x) { return 1.f / (1.f + __expf(-x)); }

__global__ void __launch_bounds__(256) k_rmsnorm(const float* in, const float* __restrict__ gain, float* out, int rows) {
    const int row = blockIdx.x * 4 + (threadIdx.x >> 6), lane = threadIdx.x & 63;
    if (row >= rows) return;
    const float4* x = (const float4*)(in + (size_t)row * D);
    const float4* g = (const float4*)gain;
    float4 v[4]; float s = 0.f;
#pragma unroll
    for (int j = 0; j < 4; ++j) { v[j] = x[lane + 64 * j]; s += v[j].x * v[j].x + v[j].y * v[j].y + v[j].z * v[j].z + v[j].w * v[j].w; }
    s = wave_sum(s);
    const float r = rsqrtf(s * (1.f / D) + EPS);
    float4* o = (float4*)(out + (size_t)row * D);
#pragma unroll
    for (int j = 0; j < 4; ++j) { const float4 gg = g[lane + 64 * j]; o[lane + 64 * j] = make_float4(v[j].x * r * gg.x, v[j].y * r * gg.y, v[j].z * r * gg.z, v[j].w * r * gg.w); }
}

__global__ void __launch_bounds__(256) k_sgemm(const float* __restrict__ A, int lda, const int* __restrict__ idx, const float* __restrict__ B, int ldb,
                                               float* __restrict__ C, int ldc, int M, const int* __restrict__ cnt, int K, int accum) {
    __shared__ float As[16][68];
    __shared__ float Bs[16][64];
    const int Mv = cnt ? *cnt : M;
    const int m0 = blockIdx.y * 64, n0 = blockIdx.x * 64;
    if (m0 >= Mv) return;
    const int tid = threadIdx.x, tx = tid & 15, ty = tid >> 4;
    float c[4][4];
#pragma unroll
    for (int i = 0; i < 4; ++i)
#pragma unroll
        for (int j = 0; j < 4; ++j) c[i][j] = 0.f;
    const int ar = tid >> 2, ak = (tid & 3) * 4;
    const int arow = m0 + ar; const bool aval = arow < Mv;
    const int asrc = aval ? (idx ? idx[arow] : arow) : 0;
    const float* Ap = A + (size_t)asrc * lda + ak;
    const int bk = tid >> 4, bn = (tid & 15) * 4;
    const float* Bp = B + (size_t)bk * ldb + n0 + bn;
    for (int k0 = 0; k0 < K; k0 += 16) {
        float4 a = make_float4(0.f, 0.f, 0.f, 0.f);
        if (aval) a = *(const float4*)(Ap + k0);
        const float4 b = *(const float4*)(Bp + (size_t)k0 * ldb);
        __syncthreads();
        As[ak + 0][ar] = a.x; As[ak + 1][ar] = a.y; As[ak + 2][ar] = a.z; As[ak + 3][ar] = a.w;
        *(float4*)&Bs[bk][bn] = b;
        __syncthreads();
#pragma unroll
        for (int kk = 0; kk < 16; ++kk) {
            const float4 av = *(const float4*)&As[kk][ty * 4];
            const float4 bv = *(const float4*)&Bs[kk][tx * 4];
            const float aa[4] = {av.x, av.y, av.z, av.w}, bb[4] = {bv.x, bv.y, bv.z, bv.w};
#pragma unroll
            for (int i = 0; i < 4; ++i)
#pragma unroll
                for (int j = 0; j < 4; ++j) c[i][j] += aa[i] * bb[j];
        }
    }
#pragma unroll
    for (int i = 0; i < 4; ++i) {
        const int row = m0 + ty * 4 + i;
        if (row < Mv) {
            float4* cp = (float4*)(C + (size_t)row * ldc + n0 + tx * 4);
            float4 o = make_float4(c[i][0], c[i][1], c[i][2], c[i][3]);
            if (accum) { const float4 old = *cp; o.x += old.x; o.y += old.y; o.z += old.z; o.w += old.w; }
            *cp = o;
        }
    }
}

__global__ void __launch_bounds__(256) k_rotary(float* __restrict__ T, int ld, const int* __restrict__ pos, float scale, int rows) {
    const int g = blockIdx.x * 256 + threadIdx.x;
    if (g >= rows * 512) return;
    const int i = g & 127, h = (g >> 7) & 3, r = g >> 9;
    const float ex = (float)i / 127.0f;
    const float invf = (float)(1.0 / pow(10000.0, (double)ex));
    const float ang = (float)pos[r] * invf;
    double t = (double)ang * 0.15915494309189535;
    t -= rint(t);
    float sn, cs; sincospif(2.0f * (float)t, &sn, &cs);
    float* p = T + (size_t)r * ld + h * 256 + i;
    const float x1 = p[0], x2 = p[128];
    p[0] = (x1 * cs - x2 * sn) * scale;
    p[128] = (x1 * sn + x2 * cs) * scale;
}

__global__ void __launch_bounds__(256) k_retention(const float* __restrict__ q, const float* __restrict__ k, const float* __restrict__ v, int ld, float* __restrict__ o, int ntok) {
    const int w = blockIdx.x * 4 + (threadIdx.x >> 6), lane = threadIdx.x & 63;
    const int h = w >> 6, e = (w & 63) * 8 + (lane >> 3), part = lane & 7;
    const float gamma = 1.0f - exp2f(-5.0f - (float)h);
    float st[32];
#pragma unroll
    for (int d = 0; d < 32; ++d) st[d] = 0.f;
    const float* qp = q + h * 256 + part * 32; const float* kp = k + h * 256 + part * 32; const float* vp = v + h * 512 + e;
    float* op = o + h * 512 + e;
#pragma unroll 2
    for (int t = 0; t < ntok; ++t) {
        const float vv = vp[(size_t)t * ld];
        float dot = 0.f;
#pragma unroll
        for (int d4 = 0; d4 < 8; ++d4) {
            const float4 kk = *(const float4*)(kp + (size_t)t * ld + d4 * 4);
            const float4 qq = *(const float4*)(qp + (size_t)t * ld + d4 * 4);
            st[d4 * 4 + 0] = gamma * st[d4 * 4 + 0] + kk.x * vv; dot += qq.x * st[d4 * 4 + 0];
            st[d4 * 4 + 1] = gamma * st[d4 * 4 + 1] + kk.y * vv; dot += qq.y * st[d4 * 4 + 1];
            st[d4 * 4 + 2] = gamma * st[d4 * 4 + 2] + kk.z * vv; dot += qq.z * st[d4 * 4 + 2];
            st[d4 * 4 + 3] = gamma * st[d4 * 4 + 3] + kk.w * vv; dot += qq.w * st[d4 * 4 + 3];
        }
        dot += __shfl_xor(dot, 1); dot += __shfl_xor(dot, 2); dot += __shfl_xor(dot, 4);
        if (part == 0) op[(size_t)t * RV] = dot;
    }
}

__global__ void __launch_bounds__(256) k_gn_gate(float* __restrict__ o, const float* __restrict__ g, int ldg, const float* __restrict__ gn, int rows) {
    const int w = blockIdx.x * 4 + (threadIdx.x >> 6), lane = threadIdx.x & 63;
    if (w >= rows * 4) return;
    const int r = w >> 2, h = w & 3;
    float4* op = (float4*)(o + (size_t)r * RV + h * 512); const float4* gp = (const float4*)(g + (size_t)r * ldg + h * 512); const float4* nn = (const float4*)(gn + h * 512);
    float4 a = op[lane], b = op[lane + 64];
    float s = a.x * a.x + a.y * a.y + a.z * a.z + a.w * a.w + b.x * b.x + b.y * b.y + b.z * b.z + b.w * b.w;
    s = wave_sum(s);
    const float rr = rsqrtf(s * (1.f / 512.f) + EPS);
    const float4 g0 = gp[lane], g1 = gp[lane + 64], n0 = nn[lane], n1 = nn[lane + 64];
    op[lane] = make_float4(silu_f(g0.x) * a.x * rr * n0.x, silu_f(g0.y) * a.y * rr * n0.y, silu_f(g0.z) * a.z * rr * n0.z, silu_f(g0.w) * a.w * rr * n0.w);
    op[lane + 64] = make_float4(silu_f(g1.x) * b.x * rr * n1.x, silu_f(g1.y) * b.y * rr * n1.y, silu_f(g1.z) * b.z * rr * n1.z, silu_f(g1.w) * b.w * rr * n1.w);
}

__global__ void __launch_bounds__(256) k_swiglu(float* __restrict__ G, const float* __restrict__ U, int ld, int ncols, int rows, const int* __restrict__ cnt) {
    const int Mv = cnt ? *cnt : rows;
    const size_t n4 = (size_t)ncols / 4;
    for (size_t i = (size_t)blockIdx.x * 256 + threadIdx.x; i < (size_t)Mv * n4; i += (size_t)gridDim.x * 256) {
        const size_t r = i / n4, c = (i % n4) * 4;
        float4* gp = (float4*)(G + r * ld + c); const float4 u = *(const float4*)(U + r * ld + c); float4 g = *gp;
        *gp = make_float4(silu_f(g.x) * u.x, silu_f(g.y) * u.y, silu_f(g.z) * u.z, silu_f(g.w) * u.w);
    }
}
__global__ void __launch_bounds__(256) k_ple_add(float* __restrict__ h, const float* __restrict__ up, const float* __restrict__ gate, size_t n4) {
    for (size_t i = (size_t)blockIdx.x * 256 + threadIdx.x; i < n4; i += (size_t)gridDim.x * 256) {
        float4 hh = ((float4*)h)[i]; const float4 u = ((const float4*)up)[i], g = ((const float4*)gate)[i];
        hh.x += u.x * sigmoid_f(g.x); hh.y += u.y * sigmoid_f(g.y); hh.z += u.z * sigmoid_f(g.z); hh.w += u.w * sigmoid_f(g.w);
        ((float4*)h)[i] = hh;
    }
}

__global__ void __launch_bounds__(256) k_band_attn(const float* __restrict__ q, const float* __restrict__ kv, const float* __restrict__ rel, float* __restrict__ o) {
    __shared__ float Ks[64][65];
    __shared__ float Vs[64][65];
    __shared__ float tab[320];
    const int c = blockIdx.x, h = blockIdx.y, tid = threadIdx.x, i = tid >> 2, part = tid & 3;
    for (int t = tid; t < 320; t += 256) tab[t] = rel[h * 320 + t];
    float qr[64], acc[64];
    const float* qp = q + (size_t)(c * 64 + i) * D + h * 64;
#pragma unroll
    for (int d = 0; d < 64; ++d) { qr[d] = qp[d] * 0.125f; acc[d] = 0.f; }
    float mx = -INFINITY, l = 0.f;
    for (int jt = 0; jt < 9; ++jt) {
        const int kc = c - 8 + jt;
        if (kc < 0) continue;
        __syncthreads();
        for (int e = tid; e < 64 * 64; e += 256) { const int r = e >> 6, d = e & 63; const float* src = kv + (size_t)(kc * 64 + r) * 2048 + h * 64 + d; Ks[r][d] = src[0]; Vs[r][d] = src[1024]; }
        __syncthreads();
        for (int kk = 0; kk < 16; ++kk) {
            const int kr = part * 16 + kk;
            float s = 0.f;
#pragma unroll
            for (int d = 0; d < 64; ++d) s += qr[d] * Ks[kr][d];
            int dist = i - kr + 64 * (8 - jt);
            dist = dist < -63 ? -63 : (dist > 256 ? 256 : dist);
            s += tab[dist + 63];
            const float mn = fmaxf(mx, s);
            const float f = __expf(mx - mn), p = __expf(s - mn);
            l = l * f + p;
#pragma unroll
            for (int d = 0; d < 64; ++d) acc[d] = acc[d] * f + p * Vs[kr][d];
            mx = mn;
        }
    }
#pragma unroll
    for (int sft = 1; sft < 4; sft <<= 1) {
        const float mo = __shfl_xor(mx, sft), lo = __shfl_xor(l, sft);
        const float mn = fmaxf(mx, mo), f0 = __expf(mx - mn), f1 = __expf(mo - mn);
        l = l * f0 + lo * f1;
#pragma unroll
        for (int d = 0; d < 64; ++d) { const float ao = __shfl_xor(acc[d], sft); acc[d] = acc[d] * f0 + ao * f1; }
        mx = mn;
    }
    if (part == 0) {
        float* op = o + (size_t)(c * 64 + i) * D + h * 64; const float inv = 1.f / l;
#pragma unroll
        for (int d = 0; d < 64; ++d) op[d] = acc[d] * inv;
    }
}

__global__ void __launch_bounds__(256) k_router(const float* __restrict__ xn, const float* __restrict__ wr, int* __restrict__ cnt, int* __restrict__ lidx, float* __restrict__ lw, int rows) {
    const int row = blockIdx.x * 4 + (threadIdx.x >> 6), lane = threadIdx.x & 63;
    if (row >= rows) return;
    float lg[8];
#pragma unroll
    for (int e = 0; e < 8; ++e) lg[e] = 0.f;
    for (int j = 0; j < 16; ++j) {
        const int kx = lane + 64 * j; const float x = xn[(size_t)row * D + kx];
        const float4 w0 = *(const float4*)(wr + (size_t)kx * 8), w1 = *(const float4*)(wr + (size_t)kx * 8 + 4);
        lg[0] += x * w0.x; lg[1] += x * w0.y; lg[2] += x * w0.z; lg[3] += x * w0.w; lg[4] += x * w1.x; lg[5] += x * w1.y; lg[6] += x * w1.z; lg[7] += x * w1.w;
    }
#pragma unroll
    for (int e = 0; e < 8; ++e) lg[e] = wave_sum(lg[e]);
    if (lane == 0) {
        int e1 = 0; float v1 = lg[0];
#pragma unroll
        for (int e = 1; e < 8; ++e) if (lg[e] > v1) { v1 = lg[e]; e1 = e; }
        int e2 = -1; float v2 = -INFINITY;
#pragma unroll
        for (int e = 0; e < 8; ++e) if (e != e1 && lg[e] > v2) { v2 = lg[e]; e2 = e; }
        const float p2 = __expf(v2 - v1), w1 = 1.f / (1.f + p2), w2 = p2 / (1.f + p2);
        const int s1 = atomicAdd(&cnt[e1], 1); lidx[e1 * rows + s1] = row; lw[e1 * rows + s1] = w1;
        const int s2 = atomicAdd(&cnt[e2], 1); lidx[e2 * rows + s2] = row; lw[e2 * rows + s2] = w2;
    }
}
__global__ void __launch_bounds__(256) k_scatter_add(float* __restrict__ h, const float* __restrict__ Y, const int* __restrict__ idx, const float* __restrict__ w, const int* __restrict__ cnt) {
    const int m = blockIdx.x * 4 + (threadIdx.x >> 6), lane = threadIdx.x & 63;
    if (m >= *cnt) return;
    const float ww = w[m]; float4* hp = (float4*)(h + (size_t)idx[m] * D); const float4* yp = (const float4*)(Y + (size_t)m * D);
#pragma unroll
    for (int j = 0; j < 4; ++j) { float4 a = hp[lane + 64 * j]; const float4 y = yp[lane + 64 * j]; a.x += ww * y.x; a.y += ww * y.y; a.z += ww * y.z; a.w += ww * y.w; hp[lane + 64 * j] = a; }
}

static void sgemm(hipStream_t st, const float* A, int lda, const int* idx, const float* B, int ldb, float* C, int ldc, int M, const int* cnt, int N, int K, int accum) {
    hipLaunchKernelGGL(k_sgemm, dim3(N / 64, (M + 63) / 64), dim3(256), 0, st, A, lda, idx, B, ldb, C, ldc, M, cnt, K, accum);
}

static void forward(void* const* d_in, float* out, unsigned char* ws, hipStream_t st) {
    const float* x = (const float*)d_in[0]; const float* p = (const float*)d_in[1]; const int* positions = (const int*)d_in[2];
    const float* norm_mix = (const float*)d_in[3]; const float* norm_ffn = (const float*)d_in[4]; const float* norm_ple = (const float*)d_in[5];
    const float* w_in_a = (const float*)d_in[6]; const float* ret_gn = (const float*)d_in[7]; const float* w_out_a = (const float*)d_in[8];
    const float* norm_kv = (const float*)d_in[9]; const float* w_kv = (const float*)d_in[10]; const float* w_q_b = (const float*)d_in[11];
    const float* rel_bias = (const float*)d_in[12]; const float* w_out_b = (const float*)d_in[13];
    const float* w_gate_dense = (const float*)d_in[14]; const float* w_up_dense = (const float*)d_in[15]; const float* w_down_dense = (const float*)d_in[16];
    const float* w_router = (const float*)d_in[17]; const float* w_gate_moe = (const float*)d_in[18]; const float* w_up_moe = (const float*)d_in[19]; const float* w_down_moe = (const float*)d_in[20];
    const float* w_ple_up = (const float*)d_in[21]; const float* w_ple_gate = (const float*)d_in[22]; const float* norm_final = (const float*)d_in[23];
    hipMemcpyAsync(out, x, (size_t)NB * S * D * 4, hipMemcpyDeviceToDevice, st);
    const size_t X1 = (size_t)S * D * 4;
    int* cnt = (int*)ws;
    int* lidx = (int*)(ws + 4096);
    float* lw = (float*)(ws + 4096 + 8 * S * 4);
    unsigned char* base = ws + (1u << 20);
    float* xn = (float*)base;
    float* bufA = (float*)(base + X1);
    for (int b = 0; b < NB; ++b) {
        float* h = out + (size_t)b * S * D;
        const int* pos = positions + b * S;
        {
            float* proj = bufA;
            float* o = (float*)((unsigned char*)bufA + 6 * X1);
            hipLaunchKernelGGL(k_rmsnorm, dim3(S / 4), dim3(256), 0, st, (const float*)h, norm_mix, xn, S);
            sgemm(st, xn, D, nullptr, w_in_a, 6144, proj, 6144, S, nullptr, 6144, D, 0);
            hipLaunchKernelGGL(k_rotary, dim3(S * 512 / 256), dim3(256), 0, st, proj, 6144, pos, 1.0f, S);
            hipLaunchKernelGGL(k_rotary, dim3(S * 512 / 256), dim3(256), 0, st, proj + 1024, 6144, pos, 0.0625f, S);
            NV_HOOK(0, proj);
            hipLaunchKernelGGL(k_retention, dim3(64), dim3(256), 0, st, (const float*)proj, (const float*)(proj + 1024), (const float*)(proj + 2048), 6144, o, S);
            NV_HOOK(1, o);
            hipLaunchKernelGGL(k_gn_gate, dim3(S), dim3(256), 0, st, o, (const float*)(proj + 4096), 6144, ret_gn, S);
            sgemm(st, o, 2048, nullptr, w_out_a, D, h, D, S, nullptr, D, 2048, 1);
            NV_HOOK(2, h);
        }
        {
            float* G = bufA; float* U = G + (size_t)S * DFF;
            hipLaunchKernelGGL(k_rmsnorm, dim3(S / 4), dim3(256), 0, st, (const float*)h, norm_ffn, xn, S);
            sgemm(st, xn, D, nullptr, w_gate_dense, DFF, G, DFF, S, nullptr, DFF, D, 0);
            sgemm(st, xn, D, nullptr, w_up_dense, DFF, U, DFF, S, nullptr, DFF, D, 0);
            hipLaunchKernelGGL(k_swiglu, dim3(4096), dim3(256), 0, st, G, (const float*)U, DFF, DFF, S, nullptr);
            sgemm(st, G, DFF, nullptr, w_down_dense, D, h, D, S, nullptr, D, DFF, 1);
            NV_HOOK(3, h);
        }
        for (int layer = 0; layer < 2; ++layer) {
            if (layer == 1) {
                float* kvb = bufA; float* qb = kvb + (size_t)S * 2048; float* ob = qb + (size_t)S * D;
                hipLaunchKernelGGL(k_rmsnorm, dim3(S / 4), dim3(256), 0, st, (const float*)h, norm_kv, xn, S);
                sgemm(st, xn, D, nullptr, w_kv, 2048, kvb, 2048, S, nullptr, 2048, D, 0);
                hipLaunchKernelGGL(k_rmsnorm, dim3(S / 4), dim3(256), 0, st, (const float*)h, norm_mix + D, xn, S);
                sgemm(st, xn, D, nullptr, w_q_b, D, qb, D, S, nullptr, D, D, 0);
                NV_HOOK(5, kvb);
                hipLaunchKernelGGL(k_band_attn, dim3(S / 64, 16), dim3(256), 0, st, (const float*)qb, (const float*)kvb, rel_bias, ob);
                NV_HOOK(6, ob);
                sgemm(st, ob, D, nullptr, w_out_b, D, h, D, S, nullptr, D, D, 1);
                NV_HOOK(7, h);
                float* G = bufA; float* U = G + (size_t)S * DFE; float* Y = U + (size_t)S * DFE;
                hipLaunchKernelGGL(k_rmsnorm, dim3(S / 4), dim3(256), 0, st, (const float*)h, norm_ffn + D, xn, S);
                hipMemsetAsync(cnt, 0, 64, st);
                hipLaunchKernelGGL(k_router, dim3(S / 4), dim3(256), 0, st, (const float*)xn, w_router, cnt, lidx, lw, S);
                for (int e = 0; e < NE; ++e) {
                    const float* wg = w_gate_moe + (size_t)e * D * DFE; const float* wu = w_up_moe + (size_t)e * D * DFE; const float* wd = w_down_moe + (size_t)e * DFE * D;
                    sgemm(st, xn, D, lidx + e * S, wg, DFE, G, DFE, S, cnt + e, DFE, D, 0);
                    sgemm(st, xn, D, lidx + e * S, wu, DFE, U, DFE, S, cnt + e, DFE, D, 0);
                    hipLaunchKernelGGL(k_swiglu, dim3(4096), dim3(256), 0, st, G, (const float*)U, DFE, DFE, S, (const int*)(cnt + e));
                    sgemm(st, G, DFE, nullptr, wd, D, Y, D, S, cnt + e, D, DFE, 0);
                    hipLaunchKernelGGL(k_scatter_add, dim3(S / 4), dim3(256), 0, st, h, (const float*)Y, (const int*)(lidx + e * S), (const float*)(lw + e * S), (const int*)(cnt + e));
                }
            }
            if (layer == 1) NV_HOOK(8, h);
            float* up = bufA; float* gate = up + (size_t)S * D;
            const float* pl = p + ((size_t)layer * NB + b) * S * PLE;
            hipLaunchKernelGGL(k_rmsnorm, dim3(S / 4), dim3(256), 0, st, (const float*)h, norm_ple + layer * D, xn, S);
            sgemm(st, xn, D, nullptr, w_ple_gate + (size_t)layer * D * D, D, gate, D, S, nullptr, D, D, 0);
            sgemm(st, pl, PLE, nullptr, w_ple_up + (size_t)layer * PLE * D, D, up, D, S, nullptr, D, PLE, 0);
            hipLaunchKernelGGL(k_ple_add, dim3(4096), dim3(256), 0, st, h, (const float*)up, (const float*)gate, (size_t)S * D / 4);
            NV_HOOK(layer == 0 ? 4 : 9, h);
        }
        hipLaunchKernelGGL(k_rmsnorm, dim3(S / 4), dim3(256), 0, st, (const float*)h, norm_final, h, S);
        NV_HOOK(10, h);
    }
}
}

namespace fx {
#define LAS __attribute__((address_space(3)))
#define GAS __attribute__((address_space(1)))
typedef unsigned short bf16_t;
typedef short bf16x8 __attribute__((ext_vector_type(8)));
typedef float f32x4 __attribute__((ext_vector_type(4)));
typedef float f32x2 __attribute__((ext_vector_type(2)));
typedef float f32x16 __attribute__((ext_vector_type(16)));
typedef unsigned u32x4 __attribute__((ext_vector_type(4)));
typedef unsigned u32x2 __attribute__((ext_vector_type(2)));
typedef int v4i_t __attribute__((ext_vector_type(4)));
typedef int v8i_t __attribute__((ext_vector_type(8)));
typedef GAS unsigned gu32;
#define RLX_AGENT __ATOMIC_RELAXED, __HIP_MEMORY_SCOPE_AGENT

constexpr int M = 16384, SEQ = 8192, D = 1024;
constexpr float EPS = 1e-6f, LOG2E = 1.4426950408889634f;
constexpr float C2Q = 0.125f * LOG2E;

__device__ __forceinline__ unsigned cvt_pk_bf16(float lo, float hi) { unsigned r; asm volatile("v_cvt_pk_bf16_f32 %0, %1, %2" : "=v"(r) : "v"(lo), "v"(hi)); return r; }
__device__ __forceinline__ float bf_lo(unsigned w) { return __uint_as_float(w << 16); }
__device__ __forceinline__ float bf_hi(unsigned w) { return __uint_as_float(w & 0xffff0000u); }
__device__ __forceinline__ float fexp2(float x) { return __builtin_amdgcn_exp2f(x); }
__device__ __forceinline__ float frcp(float x) { return __builtin_amdgcn_rcpf(x); }
__device__ __forceinline__ float frsq(float x) { return __builtin_amdgcn_rsqf(x); }
__device__ __forceinline__ float sigmoid_f(float x) { return frcp(1.f + fexp2(-LOG2E * x)); }
__device__ __forceinline__ float silu_f(float x) { return x * sigmoid_f(x); }
__device__ __forceinline__ float wave_sum(float v) {
#pragma unroll
    for (int o = 1; o < 64; o <<= 1) v += __shfl_xor(v, o);
    return v;
}
__device__ __forceinline__ float lg2gamma(int h) { return __builtin_amdgcn_logf(1.0f - fexp2(-5.0f - (float)h)); }
__device__ __forceinline__ float sum16(const float* p) {
    const f32x4* q = (const f32x4*)p; const f32x4 a = q[0], b = q[1], c = q[2], d = q[3];
    return (((a[0] + a[1]) + (a[2] + a[3])) + ((b[0] + b[1]) + (b[2] + b[3]))) + (((c[0] + c[1]) + (c[2] + c[3])) + ((d[0] + d[1]) + (d[2] + d[3])));
}
__device__ __forceinline__ float rstd16(const float* part, int tok) { return frsq(sum16(part + (size_t)tok * 16) * (1.f / 1024.f) + EPS); }

constexpr int BM = 256, BK = 64, HALF = 128, HTB = HALF * BK * 2, STAGE_BYTES = 8 * HTB;
__host__ __device__ __forceinline__ int lds_byte(int r, int c) { const int st = (r >> 4) * 2 + (c >> 5), rr = r & 15, cc = c & 31, ob = rr * 64 + cc * 2; return st * 1024 + (ob ^ (((ob >> 9) & 1) << 5)); }
__host__ __device__ __forceinline__ void stage_rc(int b, int& R, int& C) { const int st = b / 1024, sb = b % 1024, swz = sb ^ (((sb >> 9) & 1) << 5); R = (st >> 1) * 16 + swz / 64; C = (st & 1) * 32 + (swz % 64) / 2; }
__host__ __device__ __forceinline__ int perm32(int rho) { const int n = rho >> 4, i = rho & 15; return 8 * (i >> 2) + 4 * n + (i & 3); }

struct Unit { int pm, pn, kind, ex, lim; };

__device__ __forceinline__ void lin_tile(int nM, int nN, int L, int& pm, int& pn) {
    const int nwg = nM * nN;
    int wgid = L; { const int q = nwg / 8, r = nwg % 8, xcd = wgid % 8, off = wgid / 8; wgid = (xcd < r ? xcd * (q + 1) : r * (q + 1) + (xcd - r) * q) + off; }
    const int nig = 8 * nN, gid = wgid / nig, fm = gid * 8, gsz = (nM - fm) < 8 ? (nM - fm) : 8;
    pm = fm + ((wgid % nig) % gsz); pn = (wgid % nig) / gsz;
}

template <class Epi, class Sched, bool SEG2, bool GATHER, bool FP8 = false>
__device__ __forceinline__ void gemm_phase(LAS unsigned char* lds, const int lda, const int ldb, const int nt_c, const int nt0, const Sched& S, const Epi& E, const int dry = 0) {
    int nt = nt_c; asm volatile("" : "+s"(nt));
    int tid_o = threadIdx.x; asm volatile("" : "+v"(tid_o));
    const int tid = tid_o, wid = __builtin_amdgcn_readfirstlane(tid >> 6), lane = tid & 63, wr = wid >> 2, wc = wid & 3, fr = lane & 15, fq = lane >> 4;
    unsigned voffA[2], voffB[2]; int RA[2], CA[2];
#pragma unroll
    for (int i = 0; i < 2; ++i) { int R, C; stage_rc(tid * 16 + i * 8192, R, C); const int Rb = Epi::PERM ? ((R & ~31) + perm32(R & 31)) : R;
        voffA[i] = (unsigned)(R * lda + C) * 2u; voffB[i] = (unsigned)(Rb * ldb + C) * 2u; RA[i] = R; CA[i] = C; }
    const size_t kstep = (size_t)(BK * 2);
    const size_t hstepA = (size_t)HALF * lda * 2, hstepB = (size_t)HALF * ldb * 2;
    const unsigned ldsw = (unsigned)wid * 1024u;
    const int aoff = lds_byte(wr * 64 + fr, fq * 8), boff = lds_byte(wc * 32 + fr, fq * 8);
#define FG_SA(b, h) (((b) * 2 + (h)) * HTB)
#define FG_SB(b, h) ((4 + (b) * 2 + (h)) * HTB)
#define FG_STAGE2(bufoff, gbase, o0, o1) do { \
        __builtin_amdgcn_global_load_lds((const unsigned*)((const char*)(gbase) + (o0)), (LAS unsigned*)(lds + (bufoff) + ldsw), 16, 0, 0); \
        __builtin_amdgcn_global_load_lds((const unsigned*)((const char*)(gbase) + (o1)), (LAS unsigned*)(lds + (bufoff) + ldsw + 8192), 16, 0, 0); } while (0)
#define FG_STB(bufoff, gbase) FG_STAGE2(bufoff, gbase, voffB[0], voffB[1])
#define FG_STA(bufoff, gbase, h, vg) do { if constexpr (GATHER) { FG_STAGE2(bufoff, gbase, vg[h][0], vg[h][1]); } else { FG_STAGE2(bufoff, (gbase) + (h) * hstepA, voffA[0], voffA[1]); } } while (0)
#define FG_LDA(dst, b, h) do { _Pragma("unroll") for (int m = 0; m < 4; ++m) _Pragma("unroll") for (int k = 0; k < 2; ++k) dst[m][k] = *(const LAS bf16x8*)(lds + FG_SA(b, h) + aoff + m * 2048 + k * 1024); } while (0)
#define FG_LD32(p) __builtin_shufflevector(*(const LAS v4i_t*)(p), *(const LAS v4i_t*)((p) + 1024), 0, 1, 2, 3, 4, 5, 6, 7)
#define FG_LDA8(dst, b, h) do { _Pragma("unroll") for (int m = 0; m < 4; ++m) dst[m] = FG_LD32(lds + FG_SA(b, h) + aoff + m * 2048); } while (0)
#define FG_LDB8(dst, b, h) do { _Pragma("unroll") for (int n = 0; n < 2; ++n) dst[n] = FG_LD32(lds + FG_SB(b, h) + boff + n * 2048); } while (0)
#define FG_LDB(dst, b, h) do { _Pragma("unroll") for (int n = 0; n < 2; ++n) _Pragma("unroll") for (int k = 0; k < 2; ++k) dst[n][k] = *(const LAS bf16x8*)(lds + FG_SB(b, h) + boff + n * 2048 + k * 1024); } while (0)
#define FG_CAT8(x) __builtin_shufflevector(__builtin_bit_cast(v4i_t, (x)[0]), __builtin_bit_cast(v4i_t, (x)[1]), 0, 1, 2, 3, 4, 5, 6, 7)
#define FG_RDA(b, h) do { if constexpr (FP8) FG_LDA8(At8, b, h); else FG_LDA(At, b, h); } while (0)
#define FG_RDB0(b, h) do { if constexpr (FP8) FG_LDB8(B08, b, h); else FG_LDB(B0, b, h); } while (0)
#define FG_RDB1(b, h) do { if constexpr (FP8) FG_LDB8(B18, b, h); else FG_LDB(B1, b, h); } while (0)
#define FG_MMA(ai, bj, At, Bt) do { __builtin_amdgcn_s_setprio(1); \
        if constexpr (FP8) { _Pragma("unroll") for (int m = 0; m < 4; ++m) _Pragma("unroll") for (int n = 0; n < 2; ++n) \
            asm volatile("v_mfma_scale_f32_16x16x128_f8f6f4 %0, %1, %2, %0, %3, %3 op_sel_hi:[0,0,0]" : "+v"(acc[ai][bj][m][n]) : "v"(Bt##8[n]), "v"(At##8[m]), "v"(sc_one)); } \
        else { _Pragma("unroll") for (int m = 0; m < 4; ++m) _Pragma("unroll") for (int n = 0; n < 2; ++n) _Pragma("unroll") for (int k = 0; k < 2; ++k) \
            acc[ai][bj][m][n] = __builtin_amdgcn_mfma_f32_16x16x32_bf16(Bt[n][k], At[m][k], acc[ai][bj][m][n], 0, 0, 0); } \
        __builtin_amdgcn_s_setprio(0); } while (0)
#define FG_WAIT_V(n) asm volatile("s_waitcnt vmcnt(" #n ")" ::: "memory")
#define FG_WAIT_L(n) asm volatile("s_waitcnt lgkmcnt(" #n ")" ::: "memory")
#define FG_BAR __builtin_amdgcn_s_barrier()
#define FG_SCHED __builtin_amdgcn_sched_barrier(0)
#define FG_KT(s0, d, t) ((s0) + (size_t)(t) * kstep + ((SEG2 && (t) >= nt0) ? (d) : 0l))
    Unit cur, nxt; int ui = 0;
    if (!S.next(0, cur)) return;
    f32x4 acc[2][2][4][2];
#pragma unroll
    for (int a = 0; a < 2; ++a)
#pragma unroll
        for (int b = 0; b < 2; ++b)
#pragma unroll
            for (int m = 0; m < 4; ++m)
#pragma unroll
                for (int n = 0; n < 2; ++n) acc[a][b][m][n] = (f32x4){0.f, 0.f, 0.f, 0.f};
    bf16x8 At[4][2], B0[2][2], B1[2][2]; v8i_t At8[4], B08[2], B18[2];
    int sc_one = 0x7f7f7f7f; asm volatile("" : "+v"(sc_one));
    const char* cA0 = S.pa(cur); const char* cB0 = S.pb(cur);
    long dA = 0, dB = 0;
    if constexpr (SEG2) { dA = S.dA() - (long)nt0 * (long)kstep; dB = S.dB() - (long)nt0 * (long)kstep; }
    unsigned vgc[2][2], vgn[2][2], vgs[2][2];
    if constexpr (GATHER) {
#pragma unroll
        for (int h = 0; h < 2; ++h)
#pragma unroll
            for (int i = 0; i < 2; ++i) { vgc[h][i] = (unsigned)(S.arow(cur, h * HALF + RA[i]) * lda + CA[i]) * 2u; vgn[h][i] = vgc[h][i]; vgs[h][i] = vgc[h][i]; }
    } else {
#pragma unroll
        for (int h = 0; h < 2; ++h)
#pragma unroll
            for (int i = 0; i < 2; ++i) { vgc[h][i] = 0u; vgn[h][i] = 0u; vgs[h][i] = 0u; }
    }
    FG_STB(FG_SB(0, 0), cB0); FG_STB(FG_SB(0, 1), cB0 + hstepB); FG_STA(FG_SA(0, 0), cA0, 0, vgc); FG_STA(FG_SA(0, 1), cA0, 1, vgc);
    if (wr == 1) FG_BAR;
    FG_WAIT_V(2); FG_BAR;
    FG_STB(FG_SB(1, 0), cB0 + kstep); FG_STA(FG_SA(1, 0), cA0 + kstep, 0, vgc); FG_STB(FG_SB(1, 1), cB0 + hstepB + kstep);
    FG_WAIT_V(6); FG_BAR;
    for (;;) {
        const bool has_next = S.next(ui + 1, nxt);
        const char* nA0 = has_next ? S.pa(nxt) : cA0; const char* nB0 = has_next ? S.pb(nxt) : cB0;
        if constexpr (GATHER) {
            if (has_next) {
#pragma unroll
                for (int h = 0; h < 2; ++h)
#pragma unroll
                    for (int i = 0; i < 2; ++i) vgn[h][i] = (unsigned)(S.arow(nxt, h * HALF + RA[i]) * lda + CA[i]) * 2u;
            }
        }
        for (int t = 0; t < nt; t += 2) {
            const bool last = (t == nt - 2);
            const char* a1 = FG_KT(cA0, dA, t + 1);
            const char* a2 = last ? nA0 : FG_KT(cA0, dA, t + 2); const char* b2 = last ? nB0 : FG_KT(cB0, dB, t + 2);
            const char* a3 = a2 + kstep; const char* b3 = b2 + kstep;
            if constexpr (GATHER) {
#pragma unroll
                for (int h = 0; h < 2; ++h)
#pragma unroll
                    for (int i = 0; i < 2; ++i) vgs[h][i] = last ? vgn[h][i] : vgc[h][i];
            }
            FG_RDB0(0, 0); FG_RDB1(0, 1); FG_SCHED; FG_RDA(0, 0); FG_STA(FG_SA(1, 1), a1, 1, vgc);
            FG_WAIT_V(8); FG_WAIT_L(0); FG_BAR; FG_MMA(0, 0, At, B0); FG_MMA(0, 1, At, B1); FG_BAR; FG_SCHED;
            FG_RDA(0, 1); FG_STB(FG_SB(0, 0), b2); FG_STB(FG_SB(0, 1), b2 + hstepB); FG_STA(FG_SA(0, 0), a2, 0, vgs);
            FG_WAIT_V(8); FG_WAIT_L(0); FG_BAR; FG_MMA(1, 0, At, B0); FG_MMA(1, 1, At, B1); FG_BAR; FG_SCHED;
            FG_RDB0(1, 0); FG_RDB1(1, 1); FG_SCHED; FG_RDA(1, 0); FG_STA(FG_SA(0, 1), a2, 1, vgs);
            FG_WAIT_V(8); FG_WAIT_L(0); FG_BAR; FG_MMA(0, 0, At, B0); FG_MMA(0, 1, At, B1); FG_BAR; FG_SCHED;
            FG_RDA(1, 1); FG_STB(FG_SB(1, 0), b3); FG_STB(FG_SB(1, 1), b3 + hstepB); FG_STA(FG_SA(1, 0), a3, 0, vgs);
            FG_WAIT_V(8); FG_WAIT_L(0); FG_BAR; FG_MMA(1, 0, At, B0); FG_MMA(1, 1, At, B1); FG_BAR; FG_SCHED;
        }
        if (wr == 0) FG_BAR;
        if constexpr (FP8) asm volatile("s_nop 15\n\ts_nop 15\n\ts_nop 15" ::: "memory");
        { int fr_o = fr, fq_o = fq; asm volatile("" : "+v"(fr_o), "+v"(fq_o));
          if (!dry) E(acc, cur, wr, wc, fr_o, fq_o); }
        if (!has_next) break;
#pragma unroll
        for (int a = 0; a < 2; ++a)
#pragma unroll
            for (int b = 0; b < 2; ++b)
#pragma unroll
                for (int m = 0; m < 4; ++m)
#pragma unroll
                    for (int n = 0; n < 2; ++n) acc[a][b][m][n] = (f32x4){0.f, 0.f, 0.f, 0.f};
        cur = nxt; cA0 = nA0; cB0 = nB0; ++ui;
        if constexpr (GATHER) {
#pragma unroll
            for (int h = 0; h < 2; ++h)
#pragma unroll
                for (int i = 0; i < 2; ++i) vgc[h][i] = vgn[h][i];
        }
        if (wr == 1) FG_BAR;
    }
    FG_WAIT_V(0);
    FG_BAR;
#undef FG_SA
#undef FG_SB
#undef FG_STAGE2
#undef FG_STB
#undef FG_STA
#undef FG_LDA
#undef FG_LDB
#undef FG_MMA
#undef FG_CAT8
#undef FG_LD32
#undef FG_LDA8
#undef FG_LDB8
#undef FG_RDA
#undef FG_RDB0
#undef FG_RDB1
#undef FG_WAIT_V
#undef FG_WAIT_L
#undef FG_BAR
#undef FG_SCHED
#undef FG_KT
}

struct SchedGen {
    int G, c, nM, nN; const char* A; const char* B; const char* A2; const char* B2; long a_pm, a_pn, b_pm, b_pn; int a_pn_shift, b_pm_shift;
    __device__ __forceinline__ bool next(int i, Unit& u) const { const long L = (long)i * G + c; if (L >= (long)nM * nN) return false; lin_tile(nM, nN, (int)L, u.pm, u.pn); u.kind = 0; u.ex = 0; u.lim = 0; return true; }
    __device__ __forceinline__ long offa(const Unit& u) const { return (long)u.pm * a_pm + (long)(u.pn >> a_pn_shift) * a_pn; }
    __device__ __forceinline__ long offb(const Unit& u) const { return (long)(u.pm >> b_pm_shift) * b_pm + (long)u.pn * b_pn; }
    __device__ __forceinline__ const char* pa(const Unit& u) const { return A + offa(u); }
    __device__ __forceinline__ const char* pb(const Unit& u) const { return B + offb(u); }
    __device__ __forceinline__ long dA() const { return (long)(A2 - A); }
    __device__ __forceinline__ long dB() const { return (long)(B2 - B); }
    __device__ __forceinline__ int arow(const Unit&, int r) const { return r; }
};
struct SchedINA {
    int G, c; const char* hb; const char* W;
    __device__ __forceinline__ bool next(int i, Unit& u) const {
        long L = (long)i * G + c; u.ex = 0; u.lim = 0;
        if (L < 1024) { lin_tile(64, 16, (int)L, u.pm, u.pn); u.kind = u.pn < 4 ? 0 : (u.pn < 8 ? 1 : 2); return true; }
        L -= 1024; if (L >= 768) return false;
        lin_tile(12, 64, (int)L, u.pm, u.pn); u.kind = u.pm < 4 ? 3 : 4; return true;
    }
    __device__ __forceinline__ const char* pa(const Unit& u) const { return u.kind < 3 ? hb + (size_t)u.pm * (256 * 1024 * 2) : W + (size_t)(1024 + u.pm * 256) * 2048; }
    __device__ __forceinline__ const char* pb(const Unit& u) const { return u.kind < 3 ? W + (size_t)((u.pn < 8 ? u.pn : u.pn + 8) * 256) * 2048 : hb + (size_t)u.pn * (256 * 1024 * 2); }
    __device__ __forceinline__ long dA() const { return 0; }
    __device__ __forceinline__ long dB() const { return 0; }
    __device__ __forceinline__ int arow(const Unit&, int r) const { return r; }
};
struct SchedQKVB {
    int G, c; const char* hb; const char* W;
    __device__ __forceinline__ bool next(int i, Unit& u) const {
        long L = (long)i * G + c; u.ex = 0; u.lim = 0;
        if (L < 512) { lin_tile(64, 8, (int)L, u.pm, u.pn); u.kind = u.pn < 4 ? 0 : 1; return true; }
        L -= 512; if (L >= 256) return false;
        lin_tile(4, 64, (int)L, u.pm, u.pn); u.kind = 2; return true;
    }
    __device__ __forceinline__ const char* pa(const Unit& u) const { return u.kind < 2 ? hb + (size_t)u.pm * (256 * 1024 * 2) : W + (size_t)(2048 + u.pm * 256) * 2048; }
    __device__ __forceinline__ const char* pb(const Unit& u) const { return u.kind < 2 ? W + (size_t)(u.pn * 256) * 2048 : hb + (size_t)u.pn * (256 * 1024 * 2); }
    __device__ __forceinline__ long dA() const { return 0; }
    __device__ __forceinline__ long dB() const { return 0; }
    __device__ __forceinline__ int arow(const Unit&, int r) const { return r; }
};
struct SchedMoe {
    int G, c, nN; int c0, c1, c2, c3, c4, c5, c6, c7; int RT;
    const char* A; const char* B; long b_e, b_pn, a_rt, a_e; const int* tok;
    __device__ __forceinline__ void init_counts(const unsigned* cnt) {
        c0 = (int)cnt[0]; c1 = (int)cnt[1]; c2 = (int)cnt[2]; c3 = (int)cnt[3]; c4 = (int)cnt[4]; c5 = (int)cnt[5]; c6 = (int)cnt[6]; c7 = (int)cnt[7];
        RT = ((c0 + 255) >> 8) + ((c1 + 255) >> 8) + ((c2 + 255) >> 8) + ((c3 + 255) >> 8) + ((c4 + 255) >> 8) + ((c5 + 255) >> 8) + ((c6 + 255) >> 8) + ((c7 + 255) >> 8);
    }
    __device__ __forceinline__ bool next(int i, Unit& u) const {
        const long L = (long)i * G + c; if (L >= (long)RT * nN) return false;
        lin_tile(RT, nN, (int)L, u.pm, u.pn);
        int e = 0, base = 0, ce = c0, t = (c0 + 255) >> 8;
#define MOE_STEP(k, ck) if (u.pm >= t) { e = k; base = t; ce = ck; } t += (ck + 255) >> 8;
        MOE_STEP(1, c1) MOE_STEP(2, c2) MOE_STEP(3, c3) MOE_STEP(4, c4) MOE_STEP(5, c5) MOE_STEP(6, c6) MOE_STEP(7, c7)
#undef MOE_STEP
        u.kind = e; u.ex = u.pm - base; u.lim = ce - u.ex * 256; return true;
    }
    __device__ __forceinline__ const char* pa(const Unit& u) const { return A + (long)u.pm * a_rt + (long)u.kind * a_e + (long)u.ex * (a_e >> 6); }
    __device__ __forceinline__ const char* pb(const Unit& u) const { return B + (long)u.kind * b_e + (long)u.pn * b_pn; }
    __device__ __forceinline__ long dA() const { return 0; }
    __device__ __forceinline__ long dB() const { return 0; }
    __device__ __forceinline__ int arow(const Unit& u, int r) const { return r < u.lim ? tok[u.kind * 16384 + u.ex * 256 + r] : 0; }
};
#define EPI_ARGS const f32x4 (&acc)[2][2][4][2], const Unit& u, int wr, int wc, int fr, int fq
__device__ __forceinline__ u32x4 pack8(const float (&o)[8]) { u32x4 w; w.x = cvt_pk_bf16(o[0], o[1]); w.y = cvt_pk_bf16(o[2], o[3]); w.z = cvt_pk_bf16(o[4], o[5]); w.w = cvt_pk_bf16(o[6], o[7]); return w; }

__device__ __forceinline__ unsigned pk4_fp8(float a, float b, float c, float d) {
    a = __builtin_amdgcn_fmed3f(a, -448.f, 448.f); b = __builtin_amdgcn_fmed3f(b, -448.f, 448.f); c = __builtin_amdgcn_fmed3f(c, -448.f, 448.f); d = __builtin_amdgcn_fmed3f(d, -448.f, 448.f);
    int w = 0; w = __builtin_amdgcn_cvt_pk_fp8_f32(a, b, w, false); w = __builtin_amdgcn_cvt_pk_fp8_f32(c, d, w, true); return (unsigned)w; }
__device__ __forceinline__ u32x2 pack8_fp8(const float (&o)[8]) { u32x2 w; w.x = pk4_fp8(o[0], o[1], o[2], o[3]); w.y = pk4_fp8(o[4], o[5], o[6], o[7]); return w; }
constexpr float F8_SA = 4.f, F8_SW1 = 128.f, F8_SH = 16.f, F8_SW2 = 256.f;

struct EpiINA {
    static constexpr bool PERM = true;
    const float* rstd0; const f32x2* rope; bf16_t *Q, *Kp, *Gt, *KT, *VT;
    __device__ __forceinline__ void operator()(EPI_ARGS) const {
        if (u.kind <= 1) {
            const int h = u.kind == 0 ? u.pn : u.pn - 4; bf16_t* dst = u.kind == 0 ? Q : Kp; const float lg = lg2gamma(h);
#pragma unroll
            for (int ai = 0; ai < 2; ++ai)
#pragma unroll
                for (int m = 0; m < 4; ++m) {
                    const int tok = u.pm * 256 + ai * 128 + wr * 64 + m * 16 + fr;
                    float sc = rstd0[tok]; if (u.kind == 1) sc *= 0.0625f * fexp2(-(float)((tok & 255) + 1) * lg);
                    const int i0 = wc * 32 + fq * 8;
                    const f32x4* rp = (const f32x4*)(rope + (size_t)tok * 128 + i0);
                    f32x4 rr[4]; rr[0] = rp[0]; rr[1] = rp[1]; rr[2] = rp[2]; rr[3] = rp[3];
                    float o1[8], o2[8];
#pragma unroll
                    for (int n = 0; n < 2; ++n)
#pragma unroll
                        for (int j = 0; j < 4; ++j) { const int t = 4 * n + j; const float cs = rr[t >> 1][(t & 1) * 2], sn = rr[t >> 1][(t & 1) * 2 + 1];
                            const float x1 = acc[ai][0][m][n][j], x2 = acc[ai][1][m][n][j]; o1[t] = (x1 * cs - x2 * sn) * sc; o2[t] = (x1 * sn + x2 * cs) * sc; }
                    bf16_t* p = dst + (size_t)tok * 1024 + h * 256 + i0;
                    *(u32x4*)p = pack8(o1); *(u32x4*)(p + 128) = pack8(o2);
                }
        } else if (u.kind == 2) {
#pragma unroll
            for (int ai = 0; ai < 2; ++ai)
#pragma unroll
                for (int m = 0; m < 4; ++m) {
                    const int tok = u.pm * 256 + ai * 128 + wr * 64 + m * 16 + fr; const float rs = rstd0[tok];
#pragma unroll
                    for (int bj = 0; bj < 2; ++bj) { float o[8];
#pragma unroll
                        for (int n = 0; n < 2; ++n)
#pragma unroll
                            for (int j = 0; j < 4; ++j) o[4 * n + j] = silu_f(rs * acc[ai][bj][m][n][j]);
                        *(u32x4*)(Gt + (size_t)tok * 2048 + (u.pn - 8) * 256 + bj * 128 + wc * 32 + fq * 8) = pack8(o); }
                }
        } else if (u.kind == 3) {
            const int h = u.pm; const float lg = lg2gamma(h);
#pragma unroll
            for (int bj = 0; bj < 2; ++bj) {
                const int tok0 = u.pn * 256 + bj * 128 + wc * 32 + fq * 8; float sc[8];
#pragma unroll
                for (int t = 0; t < 8; ++t) sc[t] = rstd0[tok0 + t] * 0.0625f * fexp2(-(float)(((tok0 + t) & 255) + 1) * lg);
#pragma unroll
                for (int m = 0; m < 4; ++m) {
                    const int i = wr * 64 + m * 16 + fr; float o1[8], o2[8];
#pragma unroll
                    for (int n = 0; n < 2; ++n)
#pragma unroll
                        for (int j = 0; j < 4; ++j) { const int t = 4 * n + j; const f32x2 cs = rope[(size_t)(tok0 + t) * 128 + i];
                            const float x1 = acc[0][bj][m][n][j], x2 = acc[1][bj][m][n][j]; o1[t] = (x1 * cs[0] - x2 * cs[1]) * sc[t]; o2[t] = (x1 * cs[1] + x2 * cs[0]) * sc[t]; }
                    *(u32x4*)(KT + (size_t)(h * 256 + i) * M + tok0) = pack8(o1); *(u32x4*)(KT + (size_t)(h * 256 + 128 + i) * M + tok0) = pack8(o2);
                }
            }
        } else {
            const int vrow0 = (u.pm - 4) * 256;
#pragma unroll
            for (int bj = 0; bj < 2; ++bj) {
                const int tok0 = u.pn * 256 + bj * 128 + wc * 32 + fq * 8; float sc[8];
#pragma unroll
                for (int t = 0; t < 8; ++t) sc[t] = rstd0[tok0 + t];
#pragma unroll
                for (int ai = 0; ai < 2; ++ai)
#pragma unroll
                    for (int m = 0; m < 4; ++m) { float o[8];
#pragma unroll
                        for (int n = 0; n < 2; ++n)
#pragma unroll
                            for (int j = 0; j < 4; ++j) o[4 * n + j] = acc[ai][bj][m][n][j] * sc[4 * n + j];
                        *(u32x4*)(VT + (size_t)(vrow0 + ai * 128 + wr * 64 + m * 16 + fr) * M + tok0) = pack8(o); }
            }
        }
    }
};
template <bool CAUSAL> struct EpiStore {
    static constexpr bool PERM = true;
    bf16_t* O; int ld; float scale;
    __device__ __forceinline__ void operator()(EPI_ARGS) const {
#pragma unroll
        for (int ai = 0; ai < 2; ++ai)
#pragma unroll
            for (int m = 0; m < 4; ++m) {
                const int r = ai * 128 + wr * 64 + m * 16 + fr;
#pragma unroll
                for (int bj = 0; bj < 2; ++bj) { const int c0 = bj * 128 + wc * 32 + fq * 8; float o[8];
                    float fd = (float)(r - c0 + 1);
#pragma unroll
                    for (int n = 0; n < 2; ++n)
#pragma unroll
                        for (int j = 0; j < 4; ++j) { const int t = 4 * n + j; o[t] = acc[ai][bj][m][n][j] * (CAUSAL ? __builtin_amdgcn_fmed3f(fd - (float)t, 0.f, 1.f) : scale); }
                    *(u32x4*)(O + (size_t)(u.pm * 256 + r) * ld + u.pn * 256 + c0) = pack8(o); }
            }
    }
};
struct EpiR3 {
    static constexpr bool PERM = true;
    bf16_t* O; float* pgn;
    __device__ __forceinline__ void operator()(EPI_ARGS) const {
        const float lg = lg2gamma(u.pn >> 1);
#pragma unroll
        for (int ai = 0; ai < 2; ++ai)
#pragma unroll
            for (int m = 0; m < 4; ++m) {
                const int r = ai * 128 + wr * 64 + m * 16 + fr, tok = u.pm * 256 + r; const float xi = fexp2((float)(r + 1) * lg); float ss = 0.f;
#pragma unroll
                for (int bj = 0; bj < 2; ++bj) { float o[8];
#pragma unroll
                    for (int n = 0; n < 2; ++n)
#pragma unroll
                        for (int j = 0; j < 4; ++j) { const float v = acc[ai][bj][m][n][j] * xi; o[4 * n + j] = v; ss += v * v; }
                    *(u32x4*)(O + (size_t)tok * 2048 + u.pn * 256 + bj * 128 + wc * 32 + fq * 8) = pack8(o); }
                ss += __shfl_xor(ss, 16); ss += __shfl_xor(ss, 32);
                if (fq == 0) pgn[(size_t)tok * 32 + u.pn * 4 + wc] = ss;
            }
    }
};
template <int MODE> struct EpiRes {
    static constexpr bool PERM = false;
    const float* Hin; float* H; bf16_t* HB; float* pout; const float* pin; const bf16_t* U;
    __device__ __forceinline__ void operator()(EPI_ARGS) const {
#pragma unroll
        for (int ai = 0; ai < 2; ++ai)
#pragma unroll
            for (int m = 0; m < 4; ++m) {
                const int tok = u.pm * 256 + ai * 128 + wr * 64 + m * 16 + fr; float ss = 0.f; float rs = 1.f;
                if (MODE == 1) rs = rstd16(pin, tok);
#pragma unroll
                for (int bj = 0; bj < 2; ++bj)
#pragma unroll
                    for (int n = 0; n < 2; ++n) {
                        const size_t off = (size_t)tok * 1024 + u.pn * 256 + bj * 128 + wc * 32 + n * 16 + fq * 4;
                        f32x4 v = *(const f32x4*)(Hin + off); const f32x4 a = acc[ai][bj][m][n];
                        if (MODE == 1) { const u32x2 uu = *(const u32x2*)(U + off);
                            v[0] += bf_lo(uu.x) * sigmoid_f(rs * a[0]); v[1] += bf_hi(uu.x) * sigmoid_f(rs * a[1]); v[2] += bf_lo(uu.y) * sigmoid_f(rs * a[2]); v[3] += bf_hi(uu.y) * sigmoid_f(rs * a[3]);
                        } else v = v + a;
                        *(f32x4*)(H + off) = v; ss += (v[0] * v[0] + v[1] * v[1]) + (v[2] * v[2] + v[3] * v[3]);
                        if (HB) { u32x2 w; w.x = cvt_pk_bf16(v[0], v[1]); w.y = cvt_pk_bf16(v[2], v[3]); *(u32x2*)(HB + off) = w; }
                    }
                ss += __shfl_xor(ss, 16); ss += __shfl_xor(ss, 32);
                if (fq == 0) pout[(size_t)tok * 16 + u.pn * 4 + wc] = ss;
            }
    }
};
template <bool MOE> struct EpiGU {
    static constexpr bool PERM = true;
    bf16_t* Hd; int ld; const float* pin; const float* rsr; const float* gwr;
    __device__ __forceinline__ void operator()(EPI_ARGS) const {
#pragma unroll
        for (int ai = 0; ai < 2; ++ai)
#pragma unroll
            for (int m = 0; m < 4; ++m) {
                const int r = ai * 128 + wr * 64 + m * 16 + fr, row = u.pm * 256 + r; float rs, gw = 1.f; bool valid = true;
                if (MOE) { valid = r < u.lim; const int ix = u.kind * 16384 + u.ex * 256 + r; rs = valid ? rsr[ix] : 0.f; gw = valid ? gwr[ix] * F8_SH : 0.f; }
                else rs = rstd16(pin, row);
                float o[8];
                if (MOE) rs *= 1.f / (F8_SA * F8_SW1);
#pragma unroll
                for (int n = 0; n < 2; ++n)
#pragma unroll
                    for (int j = 0; j < 4; ++j) o[4 * n + j] = silu_f(rs * acc[ai][0][m][n][j]) * (rs * acc[ai][1][m][n][j]) * gw;
                if (MOE) { if (valid) *(u32x2*)((unsigned char*)Hd + (size_t)row * ld + u.pn * 128 + wc * 32 + fq * 8) = pack8_fp8(o); }
                else *(u32x4*)(Hd + (size_t)row * ld + u.pn * 128 + wc * 32 + fq * 8) = pack8(o);
            }
    }
};
struct EpiQKVB {
    static constexpr bool PERM = true;
    const float* pin; bf16_t *Qb, *Kb, *VbT;
    __device__ __forceinline__ void operator()(EPI_ARGS) const {
        if (u.kind < 2) {
            bf16_t* dst = u.kind == 0 ? Qb : Kb; const float s0 = u.kind == 0 ? C2Q : 1.f;
#pragma unroll
            for (int ai = 0; ai < 2; ++ai)
#pragma unroll
                for (int m = 0; m < 4; ++m) {
                    const int tok = u.pm * 256 + ai * 128 + wr * 64 + m * 16 + fr; const float rs = rstd16(pin, tok) * s0;
#pragma unroll
                    for (int bj = 0; bj < 2; ++bj) { float o[8];
#pragma unroll
                        for (int n = 0; n < 2; ++n)
#pragma unroll
                            for (int j = 0; j < 4; ++j) o[4 * n + j] = rs * acc[ai][bj][m][n][j];
                        *(u32x4*)(dst + (size_t)tok * 1024 + (u.pn & 3) * 256 + bj * 128 + wc * 32 + fq * 8) = pack8(o); }
                }
        } else {
#pragma unroll
            for (int bj = 0; bj < 2; ++bj) {
                const int tok0 = u.pn * 256 + bj * 128 + wc * 32 + fq * 8; float sc[8];
#pragma unroll
                for (int t = 0; t < 8; ++t) sc[t] = rstd16(pin, tok0 + t);
#pragma unroll
                for (int ai = 0; ai < 2; ++ai)
#pragma unroll
                    for (int m = 0; m < 4; ++m) { float o[8];
#pragma unroll
                        for (int n = 0; n < 2; ++n)
#pragma unroll
                            for (int j = 0; j < 4; ++j) o[4 * n + j] = acc[ai][bj][m][n][j] * sc[4 * n + j];
                        *(u32x4*)(VbT + (size_t)(u.pm * 256 + ai * 128 + wr * 64 + m * 16 + fr) * M + tok0) = pack8(o); }
            }
        }
    }
};

struct TCtx { LAS unsigned char* lds; int tid, lane, wave, vcu, G; };

__device__ __forceinline__ void cvt_item(const float* __restrict__ W, int N, const float* __restrict__ gain, bf16_t* __restrict__ dst, int dld, int mode, int row_off, LAS float* scr, int item, int lane) {
    const int nblk = N / 32, kb = item / nblk, nb = item % nblk, k0 = 64 * kb, n0 = 32 * nb;
#pragma unroll 8
    for (int i = 0; i < 32; ++i) { const int kk = 2 * i + (lane >> 5); float v = W[(size_t)(k0 + kk) * N + n0 + (lane & 31)]; if (gain) v *= gain[k0 + kk]; scr[kk * 33 + (lane & 31)] = v; }
    asm volatile("s_waitcnt lgkmcnt(0)" ::: "memory");
    const int c = lane & 7;
#pragma unroll
    for (int j = 0; j < 4; ++j) { const int n = (lane >> 3) + 8 * j; const LAS float* s = scr + (8 * c) * 33 + n;
        u32x4 o; o.x = cvt_pk_bf16(s[0 * 33], s[1 * 33]); o.y = cvt_pk_bf16(s[2 * 33], s[3 * 33]); o.z = cvt_pk_bf16(s[4 * 33], s[5 * 33]); o.w = cvt_pk_bf16(s[6 * 33], s[7 * 33]);
        const int nn = n0 + n; const int drow = mode ? ((nn >> 7) << 8) + (nn & 127) + row_off : row_off + nn;
        *(u32x4*)(dst + (size_t)drow * dld + k0 + 8 * c) = o; }
    asm volatile("s_waitcnt lgkmcnt(0)" ::: "memory");
}
__device__ __forceinline__ void cvt_item8(const float* __restrict__ W, int N, const float* __restrict__ gain, float scale, unsigned char* __restrict__ dst, int dld, int mode, int row_off, LAS float* scr, int item, int lane) {
    const int nblk = N / 32, kb = item / nblk, nb = item % nblk, k0 = 64 * kb, n0 = 32 * nb;
#pragma unroll 8
    for (int i = 0; i < 32; ++i) { const int kk = 2 * i + (lane >> 5); float v = W[(size_t)(k0 + kk) * N + n0 + (lane & 31)] * scale; if (gain) v *= gain[k0 + kk]; scr[kk * 33 + (lane & 31)] = v; }
    asm volatile("s_waitcnt lgkmcnt(0)" ::: "memory");
    const int c = lane & 7;
#pragma unroll
    for (int j = 0; j < 4; ++j) { const int n = (lane >> 3) + 8 * j; const LAS float* s = scr + (8 * c) * 33 + n;
        u32x2 o; o.x = pk4_fp8(s[0 * 33], s[1 * 33], s[2 * 33], s[3 * 33]); o.y = pk4_fp8(s[4 * 33], s[5 * 33], s[6 * 33], s[7 * 33]);
        const int nn = n0 + n; const int drow = mode ? ((nn >> 7) << 8) + (nn & 127) + row_off : row_off + nn;
        *(u32x2*)(dst + (size_t)drow * dld + k0 + 8 * c) = o; }
    asm volatile("s_waitcnt lgkmcnt(0)" ::: "memory");
}
struct CvtJob { const float* W; const float* gain; bf16_t* dst; int K, N, dld, mode, row_off; };
__device__ __forceinline__ int cvt_items(const CvtJob& j) { return (j.K / 64) * (j.N / 32); }
constexpr size_t MiB = 1u << 20;
constexpr size_t WS_CTL = 0, CTL_ZERO_BYTES = 1 * MiB;
constexpr size_t WS_PARTA = 1 * MiB, WS_PARTB = 2 * MiB, WS_PGN = 3 * MiB;
constexpr size_t WS_MTOK = 5 * MiB, WS_MRS = 5 * MiB + 512 * 1024, WS_MGW = 6 * MiB, WS_MSEL = 6 * MiB + 512 * 1024, WS_WRT = 6 * MiB + 768 * 1024, WS_RSTD0 = 7 * MiB;
constexpr size_t WS_WIN = 8 * MiB, WS_WOA = 20 * MiB, WS_WGU0 = 24 * MiB, WS_WD0 = 35 * MiB, WS_WPG0 = 41 * MiB, WS_WPG1 = 43 * MiB, WS_WPU0 = 45 * MiB, WS_WPU1 = 45 * MiB + 512 * 1024,
                 WS_WQKV = 46 * MiB, WS_WOB = 52 * MiB;
constexpr size_t WS_HBX = 56 * MiB, WS_PB = 88 * MiB, WS_U = 104 * MiB;
constexpr size_t WS_Q = 136 * MiB, WS_KP = 168 * MiB, WS_KT = 200 * MiB, WS_G = 232 * MiB, WS_VT = 296 * MiB, WS_PP = 360 * MiB, WS_UT = 392 * MiB, WS_ROPE = 456 * MiB, WS_ST = 168 * MiB;
constexpr size_t WS_O = WS_UT;
constexpr size_t WS_HD = 136 * MiB, WS_HBY = 264 * MiB, WS_WGUM = 411 * MiB, WS_WDM = 467 * MiB;
constexpr size_t WS_QB = 136 * MiB, WS_KB = 168 * MiB, WS_VBT = 200 * MiB, WS_OB = 232 * MiB;
constexpr size_t WS_HM = 136 * MiB, WS_YM = 264 * MiB, WS_XS8 = 264 * MiB, WS_END = 523 * MiB;
constexpr int CW_TMO = 0, CW_CNT = 64, CW_BAR = 4096;

#define CVT_TRY(Wp, gainp, dstp, K_, N_, dld_, mode_, roff_) { const int ni_ = ((K_) / 64) * ((N_) / 32); if (r < ni_) { cvt_item((Wp), (N_), (gainp), (dstp), (dld_), (mode_), (roff_), scr, r, T.lane); continue; } r -= ni_; }

struct Ptrs {
    const float *x, *p, *norm_mix, *norm_ffn, *norm_ple, *w_in_a, *ret_gn, *w_out_a, *norm_kv, *w_kv, *w_q_b, *rel_bias, *w_out_b, *w_gate_dense, *w_up_dense, *w_down_dense,
                *w_router, *w_gate_moe, *w_up_moe, *w_down_moe, *w_ple_up, *w_ple_gate, *norm_final;
    const int* positions; float* out; unsigned char* ws;
};

__device__ __forceinline__ void t0_prologue(const TCtx& T, const Ptrs& P) {
    unsigned char* ws = P.ws;
    LAS float* scr = (LAS float*)(T.lds + T.wave * 16384);
    const int gw = T.vcu * 8 + T.wave, NGW = T.G * 8;
    constexpr int NIT = 16 * 192 + 32 * 32 + 2 * 16 * 88 + 44 * 32 + 2 * 16 * 32 + 2 * 4 * 32 + 16 * 64 + 16 * 32 + 16 * 32;
    for (int it = gw; it < NIT; it += NGW) {
        int r = it;
        CVT_TRY(P.w_in_a, P.norm_mix, (bf16_t*)(ws + WS_WIN), 1024, 6144, 1024, 0, 0)
        CVT_TRY(P.w_out_a, P.ret_gn, (bf16_t*)(ws + WS_WOA), 2048, 1024, 2048, 0, 0)
        CVT_TRY(P.w_gate_dense, P.norm_ffn, (bf16_t*)(ws + WS_WGU0), 1024, 2816, 1024, 1, 0)
        CVT_TRY(P.w_up_dense, P.norm_ffn, (bf16_t*)(ws + WS_WGU0), 1024, 2816, 1024, 1, 128)
        CVT_TRY(P.w_down_dense, (const float*)nullptr, (bf16_t*)(ws + WS_WD0), 2816, 1024, 2816, 0, 0)
        CVT_TRY(P.w_ple_gate, P.norm_ple, (bf16_t*)(ws + WS_WPG0), 1024, 1024, 1024, 0, 0)
        CVT_TRY(P.w_ple_gate + 1024 * 1024, P.norm_ple + 1024, (bf16_t*)(ws + WS_WPG1), 1024, 1024, 1024, 0, 0)
        CVT_TRY(P.w_ple_up, (const float*)nullptr, (bf16_t*)(ws + WS_WPU0), 256, 1024, 256, 0, 0)
        CVT_TRY(P.w_ple_up + 256 * 1024, (const float*)nullptr, (bf16_t*)(ws + WS_WPU1), 256, 1024, 256, 0, 0)
        CVT_TRY(P.w_q_b, P.norm_mix + 1024, (bf16_t*)(ws + WS_WQKV), 1024, 1024, 1024, 0, 0)
        CVT_TRY(P.w_kv, P.norm_kv, (bf16_t*)(ws + WS_WQKV), 1024, 2048, 1024, 0, 1024)
        CVT_TRY(P.w_out_b, (const float*)nullptr, (bf16_t*)(ws + WS_WOB), 1024, 1024, 1024, 0, 0)
    }
    {
        bf16_t* hb = (bf16_t*)(ws + WS_HBX); float* rstd0 = (float*)(ws + WS_RSTD0);
        for (int m = gw; m < M; m += NGW) {
            const f32x4* xr = (const f32x4*)(P.x + (size_t)m * D) + T.lane; f32x4 v[4]; float s = 0.f;
#pragma unroll
            for (int j = 0; j < 4; ++j) { v[j] = xr[64 * j]; s += (v[j][0] * v[j][0] + v[j][1] * v[j][1]) + (v[j][2] * v[j][2] + v[j][3] * v[j][3]); }
            s = wave_sum(s);
            if (T.lane == 0) rstd0[m] = frsq(s * (1.f / 1024.f) + EPS);
            u32x2* o = (u32x2*)(hb + (size_t)m * D) + T.lane;
#pragma unroll
            for (int j = 0; j < 4; ++j) { u32x2 w; w.x = cvt_pk_bf16(v[j][0], v[j][1]); w.y = cvt_pk_bf16(v[j][2], v[j][3]); o[64 * j] = w; }
        }
    }
    const int gt = T.vcu * 512 + T.tid, NGT = T.G * 512;
    {
        bf16_t* pb = (bf16_t*)(ws + WS_PB);
        for (int i = gt; i < 2 * M * 256 / 8; i += NGT) { const f32x4 a = ((const f32x4*)P.p)[2 * i], b = ((const f32x4*)P.p)[2 * i + 1];
            u32x4 w; w.x = cvt_pk_bf16(a[0], a[1]); w.y = cvt_pk_bf16(a[2], a[3]); w.z = cvt_pk_bf16(b[0], b[1]); w.w = cvt_pk_bf16(b[2], b[3]); ((u32x4*)pb)[i] = w; }
    }
    {
        float* wrt = (float*)(ws + WS_WRT);
        for (int i = gt; i < 8192; i += NGT) { const int e = i >> 10, k = i & 1023; wrt[i] = P.w_router[k * 8 + e] * P.norm_ffn[1024 + k]; }
    }
    {
        LAS float* invf = (LAS float*)(T.lds + 12288);
        __syncthreads();
        if (T.tid < 128) { const float ex = (float)T.tid / 127.0f; invf[T.tid] = (float)(1.0 / pow(10000.0, (double)ex)); }
        __syncthreads();
        f32x2* rope = (f32x2*)(ws + WS_ROPE);
        for (int i = gt; i < M * 128; i += NGT) { const int tok = i >> 7, k = i & 127;
            const float ang = (float)P.positions[tok] * invf[k]; double t = (double)ang * 0.15915494309189535; t -= rint(t);
            float sn, cs; sincospif(2.0f * (float)t, &sn, &cs); rope[i] = (f32x2){cs, sn}; }
    }
}
__device__ __forceinline__ void pm1_convert(const TCtx& T, const Ptrs& P) {
    LAS float* scr = (LAS float*)(T.lds + T.wave * 16384);
    const int gw = T.vcu * 8 + T.wave, NGW = T.G * 8;
    for (int it = gw; it < 8 * 3584 + 8 * 1792; it += NGW) {
        if (it < 8 * 3584) {
            const int e = it / 3584, q = it % 3584, which = q / 1792, item = q % 1792;
            cvt_item8((which ? P.w_up_moe : P.w_gate_moe) + (size_t)e * 1024 * 3584, 3584, P.norm_ffn + 1024, F8_SW1, P.ws + WS_WGUM + (size_t)e * 7168 * 1024, 1024, 1, which * 128, scr, item, T.lane);
        } else {
            const int r = it - 8 * 3584, e = r / 1792, item = r % 1792;
            cvt_item8(P.w_down_moe + (size_t)e * 3584 * 1024, 1024, (const float*)nullptr, F8_SW2, P.ws + WS_WDM + (size_t)e * 1024 * 3584, 3584, 0, 0, scr, item, T.lane);
        }
    }
}
__device__ __forceinline__ void t_scan(const TCtx& T, const Ptrs& P) {
    const bf16_t* UT = (const bf16_t*)(P.ws + WS_UT); bf16_t* ST = (bf16_t*)(P.ws + WS_ST);
    for (int g = T.vcu * 512 + T.tid; g < 2048 * 64; g += T.G * 512) {
        const int vrow = g >> 6, b = (g >> 5) & 1, d8 = g & 31;
        const float g256 = fexp2(256.0f * lg2gamma(vrow >> 9));
        float s[8];
#pragma unroll
        for (int k = 0; k < 8; ++k) s[k] = 0.f;
        const size_t base = (size_t)vrow * M + (size_t)b * SEQ + d8 * 8;
        for (int j = 0; j < 32; ++j) {
            const u32x4 uu = *(const u32x4*)(UT + base + j * 256);
            *(u32x4*)(ST + base + j * 256) = pack8(s);
            s[0] = g256 * (s[0] + bf_lo(uu.x)); s[1] = g256 * (s[1] + bf_hi(uu.x)); s[2] = g256 * (s[2] + bf_lo(uu.y)); s[3] = g256 * (s[3] + bf_hi(uu.y));
            s[4] = g256 * (s[4] + bf_lo(uu.z)); s[5] = g256 * (s[5] + bf_hi(uu.z)); s[6] = g256 * (s[6] + bf_lo(uu.w)); s[7] = g256 * (s[7] + bf_hi(uu.w));
        }
    }
}
__device__ __forceinline__ void t_gn(const TCtx& T, const Ptrs& P) {
    bf16_t* O = (bf16_t*)(P.ws + WS_O); const bf16_t* Gt = (const bf16_t*)(P.ws + WS_G); const float* pgn = (const float*)(P.ws + WS_PGN);
    for (int tok = T.vcu * 8 + T.wave; tok < M; tok += T.G * 8) {
#pragma unroll
        for (int k = 0; k < 4; ++k) {
            const f32x4* pp = (const f32x4*)(pgn + (size_t)tok * 32 + k * 8); const f32x4 a = pp[0], b = pp[1];
            const float rs = frsq((((a[0] + a[1]) + (a[2] + a[3])) + ((b[0] + b[1]) + (b[2] + b[3]))) * (1.f / 512.f) + EPS);
            const size_t off = (size_t)tok * 2048 + k * 512 + T.lane * 8;
            const u32x4 ov = *(const u32x4*)(O + off), gv = *(const u32x4*)(Gt + off); float o[8];
            o[0] = bf_lo(ov.x) * bf_lo(gv.x) * rs; o[1] = bf_hi(ov.x) * bf_hi(gv.x) * rs; o[2] = bf_lo(ov.y) * bf_lo(gv.y) * rs; o[3] = bf_hi(ov.y) * bf_hi(gv.y) * rs;
            o[4] = bf_lo(ov.z) * bf_lo(gv.z) * rs; o[5] = bf_hi(ov.z) * bf_hi(gv.z) * rs; o[6] = bf_lo(ov.w) * bf_lo(gv.w) * rs; o[7] = bf_hi(ov.w) * bf_hi(gv.w) * rs;
            *(u32x4*)(O + off) = pack8(o);
        }
    }
}
__device__ __forceinline__ void t_router(const TCtx& T, const Ptrs& P) {
    LAS float* wl = (LAS float*)T.lds;
    LAS int* se = (LAS int*)(T.lds + 32768);
    LAS float* sw = (LAS float*)(T.lds + 32768 + 512);
    const float* wrt = (const float*)(P.ws + WS_WRT);
    __syncthreads();
    for (int i = T.tid; i < 8192; i += 512) wl[i] = wrt[i];
    __syncthreads();
    unsigned* cnt = (unsigned*)(P.ws + WS_CTL) + CW_CNT;
    int* mtok = (int*)(P.ws + WS_MTOK); float* mrs = (float*)(P.ws + WS_MRS); float* mgw = (float*)(P.ws + WS_MGW); int* msel = (int*)(P.ws + WS_MSEL);
    for (int tb = T.vcu; tb < M / 64; tb += T.G) {
        for (int j = 0; j < 8; ++j) {
            const int lt = T.wave * 8 + j, tok = tb * 64 + lt;
            const f32x4* hr = (const f32x4*)(P.out + (size_t)tok * D) + T.lane; f32x4 v[4]; float ss = 0.f; float lg[8];
#pragma unroll
            for (int q = 0; q < 4; ++q) { v[q] = hr[64 * q]; ss += (v[q][0] * v[q][0] + v[q][1] * v[q][1]) + (v[q][2] * v[q][2] + v[q][3] * v[q][3]); }
#pragma unroll
            for (int e = 0; e < 8; ++e) { float a = 0.f;
#pragma unroll
                for (int q = 0; q < 4; ++q) { const f32x4 w = *(const LAS f32x4*)(wl + e * 1024 + 4 * (T.lane + 64 * q)); a += (v[q][0] * w[0] + v[q][1] * w[1]) + (v[q][2] * w[2] + v[q][3] * w[3]); }
                lg[e] = wave_sum(a); }
            ss = wave_sum(ss);
            if (T.lane == 0) {
                const float rs = frsq(ss * (1.f / 1024.f) + EPS);
                int e1 = 0; float v1 = lg[0];
#pragma unroll
                for (int e = 1; e < 8; ++e) if (lg[e] > v1) { v1 = lg[e]; e1 = e; }
                int e2 = 0; float v2 = -INFINITY;
#pragma unroll
                for (int e = 0; e < 8; ++e) if (e != e1 && lg[e] > v2) { v2 = lg[e]; e2 = e; }
                const float p2 = __expf((v2 - v1) * rs), w1 = 1.f / (1.f + p2), w2 = p2 / (1.f + p2);
                se[lt * 2] = e1; se[lt * 2 + 1] = e2; sw[lt * 3] = w1; sw[lt * 3 + 1] = w2; sw[lt * 3 + 2] = rs;
            }
        }
        __syncthreads();
        if (T.wave == 0) {
            const int e1 = se[T.lane * 2], e2 = se[T.lane * 2 + 1]; int r1 = 0, r2 = 0;
            const unsigned long long ltm = (1ull << T.lane) - 1ull;
#pragma unroll
            for (int e = 0; e < 8; ++e) {
                const unsigned long long m1 = __ballot(e1 == e), m2 = __ballot(e2 == e);
                const int n1 = __popcll(m1), n = n1 + __popcll(m2);
                unsigned base = 0u;
                if (T.lane == 0 && n > 0) base = __hip_atomic_fetch_add(cnt + e, (unsigned)n, RLX_AGENT);
                base = (unsigned)__builtin_amdgcn_readfirstlane((int)base);
                if (e1 == e) r1 = (int)base + __popcll(m1 & ltm);
                if (e2 == e) r2 = (int)base + n1 + __popcll(m2 & ltm);
            }
            const int tok = tb * 64 + T.lane; const float w1 = sw[T.lane * 3], w2 = sw[T.lane * 3 + 1], rs = sw[T.lane * 3 + 2];
            mtok[e1 * 16384 + r1] = tok; mrs[e1 * 16384 + r1] = rs; mgw[e1 * 16384 + r1] = w1;
            mtok[e2 * 16384 + r2] = tok; mrs[e2 * 16384 + r2] = rs; mgw[e2 * 16384 + r2] = w2;
            *(int4*)(msel + tok * 4) = make_int4(e1, r1, e2, r2);
            se[T.lane * 2] = e1 * 16384 + r1; se[T.lane * 2 + 1] = e2 * 16384 + r2;
        }
        __syncthreads();
        for (int j = 0; j < 8; ++j) {
            const int lt = T.wave * 8 + j, tok = tb * 64 + lt; const int d1 = se[lt * 2], d2 = se[lt * 2 + 1];
            const f32x4* hr = (const f32x4*)(P.out + (size_t)tok * D) + T.lane * 4; const f32x4 a = hr[0], b = hr[1], c = hr[2], d = hr[3];
            u32x4 w; w.x = pk4_fp8(F8_SA * a[0], F8_SA * a[1], F8_SA * a[2], F8_SA * a[3]); w.y = pk4_fp8(F8_SA * b[0], F8_SA * b[1], F8_SA * b[2], F8_SA * b[3]);
            w.z = pk4_fp8(F8_SA * c[0], F8_SA * c[1], F8_SA * c[2], F8_SA * c[3]); w.w = pk4_fp8(F8_SA * d[0], F8_SA * d[1], F8_SA * d[2], F8_SA * d[3]);
            unsigned char* xs = P.ws + WS_XS8;
            *(u32x4*)(xs + (size_t)d1 * 1024 + T.lane * 16) = w; *(u32x4*)(xs + (size_t)d2 * 1024 + T.lane * 16) = w;
        }
        __syncthreads();
    }
}
__device__ __forceinline__ void t_combine(const TCtx& T, const Ptrs& P, bf16_t* hb, float* pout) {
    const unsigned* cnt = (const unsigned*)(P.ws + WS_CTL) + CW_CNT; const int* msel = (const int*)(P.ws + WS_MSEL); const bf16_t* Y = (const bf16_t*)(P.ws + WS_YM);
    int tp[8]; { int t = 0;
#pragma unroll
        for (int e = 0; e < 8; ++e) { tp[e] = t; t += ((int)cnt[e] + 255) >> 8; } }
    for (int tok = T.vcu * 8 + T.wave; tok < M; tok += T.G * 8) {
        const int4 s4 = *(const int4*)(msel + tok * 4); int b1 = 0, b2 = 0;
#pragma unroll
        for (int e = 0; e < 8; ++e) { if (s4.x == e) b1 = tp[e]; if (s4.z == e) b2 = tp[e]; }
        const size_t s1 = (size_t)(b1 * 256 + s4.y), s2 = (size_t)(b2 * 256 + s4.w); float ss = 0.f;
#pragma unroll
        for (int q = 0; q < 2; ++q) {
            const int c0 = (T.lane + 64 * q) * 8; float* hp = P.out + (size_t)tok * D + c0;
            f32x4 a = *(const f32x4*)hp, b = *(const f32x4*)(hp + 4); const u32x4 y1 = *(const u32x4*)(Y + s1 * 1024 + c0), y2 = *(const u32x4*)(Y + s2 * 1024 + c0);
            a[0] += bf_lo(y1.x) + bf_lo(y2.x); a[1] += bf_hi(y1.x) + bf_hi(y2.x); a[2] += bf_lo(y1.y) + bf_lo(y2.y); a[3] += bf_hi(y1.y) + bf_hi(y2.y);
            b[0] += bf_lo(y1.z) + bf_lo(y2.z); b[1] += bf_hi(y1.z) + bf_hi(y2.z); b[2] += bf_lo(y1.w) + bf_lo(y2.w); b[3] += bf_hi(y1.w) + bf_hi(y2.w);
            *(f32x4*)hp = a; *(f32x4*)(hp + 4) = b;
            ss += ((a[0] * a[0] + a[1] * a[1]) + (a[2] * a[2] + a[3] * a[3])) + ((b[0] * b[0] + b[1] * b[1]) + (b[2] * b[2] + b[3] * b[3]));
            u32x4 w; w.x = cvt_pk_bf16(a[0], a[1]); w.y = cvt_pk_bf16(a[2], a[3]); w.z = cvt_pk_bf16(b[0], b[1]); w.w = cvt_pk_bf16(b[2], b[3]); *(u32x4*)(hb + (size_t)tok * D + c0) = w;
        }
        ss = wave_sum(ss);
        if (T.lane < 16) pout[(size_t)tok * 16 + T.lane] = T.lane == 0 ? ss : 0.f;
    }
}
__device__ __forceinline__ void t_final(const TCtx& T, const Ptrs& P, const float* pin) {
    for (int tok = T.vcu * 8 + T.wave; tok < M; tok += T.G * 8) {
        const float rs = rstd16(pin, tok); f32x4* hr = (f32x4*)(P.out + (size_t)tok * D) + T.lane; const f32x4* gg = (const f32x4*)P.norm_final + T.lane;
#pragma unroll
        for (int q = 0; q < 4; ++q) { f32x4 v = hr[64 * q]; const f32x4 g = gg[64 * q]; v = v * rs; v = v * g; hr[64 * q] = v; }
    }
}

__device__ __forceinline__ int crow(int r, int hi) { return (r & 3) + 8 * (r >> 2) + 4 * hi; }
constexpr int AT_NS = 6, AT_PD = 5, AT_TAB = 24576, AT_STAGE = 16384;
__device__ __forceinline__ void attn_phase(const TCtx& T, const Ptrs& P) {
    const bf16_t* Qb = (const bf16_t*)(P.ws + WS_QB); const bf16_t* Kb = (const bf16_t*)(P.ws + WS_KB); const bf16_t* VbT = (const bf16_t*)(P.ws + WS_VBT); bf16_t* Ob = (bf16_t*)(P.ws + WS_OB);
    LAS float* tab = (LAS float*)T.lds;
    LAS unsigned char* ring = T.lds + AT_TAB;
    __syncthreads();
    for (int i = T.tid; i < 16 * 384; i += 512) { const int hh = i / 384, k = i % 384; tab[i] = P.rel_bias[hh * 320 + (k < 319 ? k : 319)] * LOG2E; }
    __syncthreads();
    const int l = T.lane & 31, hi = T.lane >> 5, w = T.wave;
    for (int unit = T.vcu; unit < 1024; unit += T.G) {
        const int b = unit >> 9, h = (unit >> 5) & 15, cq = unit & 31;
        const int c = 4 * cq + (w >> 1), half = w & 1;
        const int tokq = b * SEQ + c * 64 + half * 32 + l;
        bf16x8 qr[4];
#pragma unroll
        for (int d0 = 0; d0 < 4; ++d0) qr[d0] = *(const bf16x8*)(Qb + (size_t)tokq * D + h * 64 + 16 * d0 + 8 * hi);
        f32x16 o0 = {}, o1 = {}; float mrun = 0.f, lsum = 0.f; bool first = true;
        const LAS float* tb = tab + h * 384;
        const int iq = half * 32 + l;
        const int kc_lo = (4 * cq - 8) > 0 ? (4 * cq - 8) : 0, NT = 4 * cq + 4 - kc_lo;
        const bf16_t* ksrc = Kb + (size_t)(b * SEQ + kc_lo * 64 + T.lane) * D + h * 64 + 8 * w;
        const bf16_t* vsrc = VbT + (size_t)(h * 64 + T.lane) * M + b * SEQ + kc_lo * 64 + 8 * w;
#define AT_ISSUE(t_) do { const int st_ = (t_) % AT_NS; \
        __builtin_amdgcn_global_load_lds((const unsigned*)(ksrc + (size_t)(t_) * 64 * D), (LAS unsigned*)(ring + st_ * AT_STAGE + w * 1024), 16, 0, 0); \
        __builtin_amdgcn_global_load_lds((const unsigned*)(vsrc + (size_t)(t_) * 64), (LAS unsigned*)(ring + st_ * AT_STAGE + 8192 + w * 1024), 16, 0, 0); } while (0)
        for (int t = 0; t < AT_PD && t < NT; ++t) AT_ISSUE(t);
        for (int t = 0; t < NT; ++t) {
            const int rem = (NT - 1 - t) < (AT_PD - 1) ? (NT - 1 - t) : (AT_PD - 1);
            if (rem >= 4) asm volatile("s_waitcnt vmcnt(8)" ::: "memory");
            else if (rem == 3) asm volatile("s_waitcnt vmcnt(6)" ::: "memory");
            else if (rem == 2) asm volatile("s_waitcnt vmcnt(4)" ::: "memory");
            else if (rem == 1) asm volatile("s_waitcnt vmcnt(2)" ::: "memory");
            else asm volatile("s_waitcnt vmcnt(0)" ::: "memory");
            __builtin_amdgcn_s_barrier(); asm volatile("" ::: "memory");
            if (t + AT_PD < NT) AT_ISSUE(t + AT_PD);
            const int kc = kc_lo + t, jt = kc - (c - 8);
            if (jt >= 0 && jt <= 8) {
                const LAS unsigned char* ks = ring + (t % AT_NS) * AT_STAGE; const LAS unsigned char* vs = ks + 8192;
                f32x16 s0, s1;
                if (jt <= 3) { const float ci = tb[319] - mrun;
#pragma unroll
                    for (int r = 0; r < 16; ++r) { s0[r] = ci; s1[r] = ci; }
                } else {
                    const LAS float* pb = tb + (iq + 64 * (8 - jt) - 4 * hi);
#pragma unroll
                    for (int r = 0; r < 16; ++r) { s0[r] = pb[63 - ((r & 3) + 8 * (r >> 2))] - mrun; s1[r] = pb[31 - ((r & 3) + 8 * (r >> 2))] - mrun; }
                }
#pragma unroll
                for (int d0 = 0; d0 < 4; ++d0) {
                    const bf16x8 k0 = *(const LAS bf16x8*)(ks + ((2 * d0 + hi) * 64 + l) * 16), k1 = *(const LAS bf16x8*)(ks + ((2 * d0 + hi) * 64 + 32 + l) * 16);
                    s0 = __builtin_amdgcn_mfma_f32_32x32x16_bf16(k0, qr[d0], s0, 0, 0, 0); s1 = __builtin_amdgcn_mfma_f32_32x32x16_bf16(k1, qr[d0], s1, 0, 0, 0);
                }
                float mx = fmaxf(s0[0], s1[0]);
#pragma unroll
                for (int r = 1; r < 16; ++r) mx = fmaxf(fmaxf(mx, s0[r]), s1[r]);
                mx = fmaxf(mx, __shfl_xor(mx, 32));
                if (first || __any(mx > 8.0f)) {
                    const float dl = first ? mx : fmaxf(mx, 0.f), f = first ? 1.f : fexp2(-dl); mrun += dl; lsum *= f;
#pragma unroll
                    for (int r = 0; r < 16; ++r) { s0[r] -= dl; s1[r] -= dl; o0[r] *= f; o1[r] *= f; }
                    first = false;
                }
                float ps = 0.f;
#pragma unroll
                for (int r = 0; r < 16; ++r) { s0[r] = fexp2(s0[r]); s1[r] = fexp2(s1[r]); ps += s0[r] + s1[r]; }
                lsum += ps;
#pragma unroll
                for (int s4 = 0; s4 < 4; ++s4) {
                    u32x4 pw;
                    if (s4 < 2) { pw.x = cvt_pk_bf16(s0[8 * s4 + 0], s0[8 * s4 + 1]); pw.y = cvt_pk_bf16(s0[8 * s4 + 2], s0[8 * s4 + 3]); pw.z = cvt_pk_bf16(s0[8 * s4 + 4], s0[8 * s4 + 5]); pw.w = cvt_pk_bf16(s0[8 * s4 + 6], s0[8 * s4 + 7]); }
                    else { const int k2 = s4 - 2; pw.x = cvt_pk_bf16(s1[8 * k2 + 0], s1[8 * k2 + 1]); pw.y = cvt_pk_bf16(s1[8 * k2 + 2], s1[8 * k2 + 3]); pw.z = cvt_pk_bf16(s1[8 * k2 + 4], s1[8 * k2 + 5]); pw.w = cvt_pk_bf16(s1[8 * k2 + 6], s1[8 * k2 + 7]); }
                    const bf16x8 pf = __builtin_bit_cast(bf16x8, pw);
#pragma unroll
                    for (int db = 0; db < 2; ++db) {
                        const u32x2 va = *(const LAS u32x2*)(vs + ((2 * s4) * 64 + 32 * db + l) * 16 + 8 * hi), vb = *(const LAS u32x2*)(vs + ((2 * s4 + 1) * 64 + 32 * db + l) * 16 + 8 * hi);
                        const u32x4 vw = {va.x, va.y, vb.x, vb.y};
                        if (db == 0) o0 = __builtin_amdgcn_mfma_f32_32x32x16_bf16(__builtin_bit_cast(bf16x8, vw), pf, o0, 0, 0, 0);
                        else o1 = __builtin_amdgcn_mfma_f32_32x32x16_bf16(__builtin_bit_cast(bf16x8, vw), pf, o1, 0, 0, 0);
                    }
                }
            }
        }
#undef AT_ISSUE
        lsum += __shfl_xor(lsum, 32);
        const float inv = frcp(lsum);
        bf16_t* op = Ob + (size_t)tokq * D + h * 64 + 4 * hi;
#pragma unroll
        for (int g4 = 0; g4 < 4; ++g4) {
            u32x2 w0, w1; w0.x = cvt_pk_bf16(o0[4 * g4] * inv, o0[4 * g4 + 1] * inv); w0.y = cvt_pk_bf16(o0[4 * g4 + 2] * inv, o0[4 * g4 + 3] * inv);
            w1.x = cvt_pk_bf16(o1[4 * g4] * inv, o1[4 * g4 + 1] * inv); w1.y = cvt_pk_bf16(o1[4 * g4 + 2] * inv, o1[4 * g4 + 3] * inv);
            *(u32x2*)(op + 8 * g4) = w0; *(u32x2*)(op + 32 + 8 * g4) = w1;
        }
        asm volatile("s_waitcnt vmcnt(0) lgkmcnt(0)" ::: "memory"); __builtin_amdgcn_s_barrier(); asm volatile("" ::: "memory");
    }
}
#define XB_TMO      128
#define XB_XCNT(j)  (256  + 64 * (j))
#define XB_XSUB(j)  (1280 + 64 * (j))
#define XB_XGEN(j)  (2304 + 64 * (j))
#define XB_TOP      3328
#define XB_TOPGEN   3392
#define XCD_BAR_WORDS 3456
#define XB_SPIN_CAP (1u << 18)

__device__ __forceinline__ unsigned xb_ld(unsigned* p)              { return __hip_atomic_load(p, __ATOMIC_RELAXED, __HIP_MEMORY_SCOPE_AGENT); }
__device__ __forceinline__ unsigned xb_add(unsigned* p, unsigned v) { return __hip_atomic_fetch_add(p, v, __ATOMIC_RELAXED, __HIP_MEMORY_SCOPE_AGENT); }
__device__ __forceinline__ unsigned xb_xcc_id() { return (unsigned)__builtin_amdgcn_s_getreg((3 << 11) | 20) & 0xFu; }
#define XB_SPIN(cond, bar) do { unsigned _sp = 0; while (cond) { __builtin_amdgcn_s_sleep(1); \
    if ((++_sp & 255u) == 0u) { if (xb_ld(&(bar)[XB_TMO])) break; if (_sp > XB_SPIN_CAP) { atomicAdd(&(bar)[XB_TMO], 1u); break; } } } } while (0)

struct XcdBarrier {
    unsigned* bar; unsigned x;
    volatile LAS unsigned* st;
};

__device__ __forceinline__ XcdBarrier xcd_barrier_post(unsigned* bar, volatile LAS unsigned* st) {
    XcdBarrier b; b.bar = bar; b.x = xb_xcc_id(); b.st = st;
    if (threadIdx.x == 0) (void)xb_add(&bar[XB_XCNT(b.x)], 1u);
    return b;
}
__device__ __forceinline__ void xcd_barrier_complete(unsigned* bar, unsigned x, unsigned& nloc, unsigned& nx) {
    const unsigned G = gridDim.x * gridDim.y * gridDim.z;
    unsigned sum, cnt, mine, sp = 0u;
    for (;;) {
        sum = 0u; cnt = 0u; mine = 0u;
#pragma unroll
        for (unsigned j = 0; j < 16; ++j) { const unsigned c = xb_ld(&bar[XB_XCNT(j)]); sum += c; cnt += (c > 0u) ? 1u : 0u; mine = (j == x) ? c : mine; }
        if (sum == G) break;
        __builtin_amdgcn_s_sleep(1);
        if ((++sp & 255u) == 0u) { if (xb_ld(&bar[XB_TMO])) break; if (sp > XB_SPIN_CAP) { atomicAdd(&bar[XB_TMO], 1u); break; } }
    }
    nloc = mine > 0u ? mine : 1u; nx = cnt > 0u ? cnt : 1u;
}

__device__ __forceinline__ void xcd_barrier(const XcdBarrier& b) {
    asm volatile("s_waitcnt vmcnt(0)" ::: "memory");
    __syncthreads();
    if (threadIdx.x == 0) {
        unsigned* bar = b.bar;
        __builtin_amdgcn_s_waitcnt(0);
        unsigned nloc = b.st[0], nx = b.st[1];
        if (nloc == 0u) { xcd_barrier_complete(bar, b.x, nloc, nx); b.st[0] = nloc; b.st[1] = nx; }
        const unsigned old = xb_add(&bar[XB_XSUB(b.x)], 1u);
        const unsigned gen = old / nloc;
        if (old + 1u == (gen + 1u) * nloc) {
            __builtin_amdgcn_fence(__ATOMIC_RELEASE, "agent");
            asm volatile("s_waitcnt vmcnt(0)" ::: "memory");
            const unsigned og = xb_add(&bar[XB_TOP], 1u);
            const unsigned tg = og / nx;
            if (og + 1u == (tg + 1u) * nx) xb_add(&bar[XB_TOPGEN], 1u);
            else XB_SPIN(xb_ld(&bar[XB_TOPGEN]) == tg, bar);
            __builtin_amdgcn_fence(__ATOMIC_ACQUIRE, "agent");
            xb_add(&bar[XB_XGEN(b.x)], 1u);
            asm volatile("s_waitcnt vmcnt(0)" ::: "memory");
        } else {
            XB_SPIN(xb_ld(&bar[XB_XGEN(b.x)]) == gen, bar);
            __builtin_amdgcn_fence(__ATOMIC_ACQUIRE, "agent");
            asm volatile("s_waitcnt vmcnt(0)" ::: "memory");
        }
    }
    __syncthreads();
}

constexpr int LDS_RING = 131072, LDS_MISC = LDS_RING, LDS_BYTES = 147456;
constexpr int NPH = 20;
struct Args { const void* in[24]; float* out; unsigned char* ws; int ph_lo, ph_hi, use_bar, pad; };

__global__ void __launch_bounds__(512, 2) fwd(Args a) {
    extern __shared__ __attribute__((aligned(16))) unsigned char lds_raw[];
    LAS unsigned char* lds = (LAS unsigned char*)lds_raw;
    TCtx T; T.lds = lds; T.tid = threadIdx.x; T.lane = T.tid & 63; T.wave = __builtin_amdgcn_readfirstlane(T.tid >> 6); T.G = gridDim.x;
    { const int bx = blockIdx.x; T.vcu = (T.G % 8 == 0) ? (bx % 8) * (T.G / 8) + bx / 8 : bx; }
    typedef const Args __attribute__((address_space(4))) CArgs;
    CArgs* ap = (CArgs*)__builtin_amdgcn_kernarg_segment_ptr();
#define LOAD_P() Ptrs P; { asm volatile("" : "+s"(ap)); \
    P.x = (const float*)ap->in[0]; P.p = (const float*)ap->in[1]; P.positions = (const int*)ap->in[2]; P.norm_mix = (const float*)ap->in[3]; P.norm_ffn = (const float*)ap->in[4]; P.norm_ple = (const float*)ap->in[5]; \
    P.w_in_a = (const float*)ap->in[6]; P.ret_gn = (const float*)ap->in[7]; P.w_out_a = (const float*)ap->in[8]; P.norm_kv = (const float*)ap->in[9]; P.w_kv = (const float*)ap->in[10]; P.w_q_b = (const float*)ap->in[11]; \
    P.rel_bias = (const float*)ap->in[12]; P.w_out_b = (const float*)ap->in[13]; P.w_gate_dense = (const float*)ap->in[14]; P.w_up_dense = (const float*)ap->in[15]; P.w_down_dense = (const float*)ap->in[16]; \
    P.w_router = (const float*)ap->in[17]; P.w_gate_moe = (const float*)ap->in[18]; P.w_up_moe = (const float*)ap->in[19]; P.w_down_moe = (const float*)ap->in[20]; P.w_ple_up = (const float*)ap->in[21]; \
    P.w_ple_gate = (const float*)ap->in[22]; P.norm_final = (const float*)ap->in[23]; P.out = ap->out; P.ws = ap->ws; }
    unsigned char* ws = a.ws;
    volatile LAS unsigned* MISC = (volatile LAS unsigned*)(lds + LDS_MISC);
    if (T.tid < 64) ((LAS unsigned*)(lds + LDS_MISC))[T.tid] = 0u;
    __syncthreads();
    XcdBarrier bar; bar.bar = (unsigned*)(ws + WS_CTL) + CW_BAR; bar.x = 0; bar.st = nullptr;
    if (a.use_bar) bar = xcd_barrier_post((unsigned*)(ws + WS_CTL) + CW_BAR, MISC + 8);
    const int lo = a.ph_lo, hi = a.ph_hi, G = T.G, c = (int)blockIdx.x;
#ifndef PH_MASK
#define PH_MASK 0x1fffff
#endif
#define IN(k) ((((PH_MASK) >> (k)) & 1) && lo <= (k) && (k) < hi)
#ifndef DUP_MASK
#define DUP_MASK 0
#endif
#define REP(k) for (int rep_ = 0; rep_ < ((((DUP_MASK) >> (k)) & 1) + 1); ++rep_)
#define SEAM(k) do { if (IN((k) + 1)) xcd_barrier(bar); } while (0)
    bf16_t* hbX = (bf16_t*)(ws + WS_HBX); bf16_t* hbY = (bf16_t*)(ws + WS_HBY);
    float* partA = (float*)(ws + WS_PARTA); float* partB = (float*)(ws + WS_PARTB);

    if (IN(0)) { LOAD_P(); REP(0) t0_prologue(T, P); SEAM(0); }
    if (IN(1)) { LOAD_P(); (void)P;
        SchedINA S{G, c, (const char*)hbX, (const char*)(ws + WS_WIN)};
        EpiINA E{(const float*)(ws + WS_RSTD0), (const f32x2*)(ws + WS_ROPE), (bf16_t*)(ws + WS_Q), (bf16_t*)(ws + WS_KP), (bf16_t*)(ws + WS_G), (bf16_t*)(ws + WS_KT), (bf16_t*)(ws + WS_VT)};
        REP(1) gemm_phase<EpiINA, SchedINA, false, false>(lds, 1024, 1024, 16, 16, S, E, (rep_ == 0 && ((DUP_MASK >> 1) & 1)) ? 1 : 0);
        SEAM(1);
    }
    if (IN(2)) { LOAD_P(); (void)P;
#ifndef P2SEL
#define P2SEL 7
#endif
        if (P2SEL & 1) { SchedGen S{G, c, 64, 4, (const char*)(ws + WS_Q), (const char*)(ws + WS_KP), nullptr, nullptr, 524288, 512, 524288, 512, 0, 0};
          EpiStore<true> E{(bf16_t*)(ws + WS_PP), 1024, 1.f};
          gemm_phase<EpiStore<true>, SchedGen, false, false>(lds, 1024, 1024, 4, 4, S, E); }
        if (P2SEL & 2) { SchedGen S{G, c, 8, 64, (const char*)(ws + WS_VT), (const char*)(ws + WS_KT), nullptr, nullptr, 8388608, 512, 8388608, 512, 0, 1};
          EpiStore<false> E{(bf16_t*)(ws + WS_UT), 16384, 1.f};
          REP(2) gemm_phase<EpiStore<false>, SchedGen, false, false>(lds, 16384, 16384, 4, 4, S, E, (rep_ == 0 && ((DUP_MASK >> 2) & 1)) ? 1 : 0); }
        if (P2SEL & 4) { SchedGen S{G, c, 64, 4, (const char*)(ws + WS_PB), (const char*)(ws + WS_WPU0), nullptr, nullptr, 131072, 0, 0, 131072, 0, 0};
          EpiStore<false> E{(bf16_t*)(ws + WS_U), 1024, 1.f};
          gemm_phase<EpiStore<false>, SchedGen, false, false>(lds, 256, 256, 4, 4, S, E); }
        SEAM(2);
    }
    if (IN(3)) { LOAD_P(); REP(3) t_scan(T, P); SEAM(3); }
    if (IN(4)) { LOAD_P(); (void)P;
        SchedGen S{G, c, 64, 8, (const char*)(ws + WS_PP), (const char*)(ws + WS_VT), (const char*)(ws + WS_Q), (const char*)(ws + WS_ST), 524288, 512, 512, 8388608, 1, 0};
        EpiR3 E{(bf16_t*)(ws + WS_O), (float*)(ws + WS_PGN)};
        REP(4) gemm_phase<EpiR3, SchedGen, true, false>(lds, 1024, 16384, 8, 4, S, E, (rep_ == 0 && ((DUP_MASK >> 4) & 1)) ? 1 : 0);
        SEAM(4);
    }
    if (IN(5)) { LOAD_P(); t_gn(T, P); SEAM(5); }
    if (IN(6)) { LOAD_P(); (void)P;
        SchedGen S{G, c, 64, 4, (const char*)(ws + WS_O), (const char*)(ws + WS_WOA), nullptr, nullptr, 1048576, 0, 0, 1048576, 0, 0};
        EpiRes<0> E{P.x, P.out, hbX, partB, nullptr, nullptr};
        REP(6) gemm_phase<EpiRes<0>, SchedGen, false, false>(lds, 2048, 2048, 32, 32, S, E, (rep_ == 0 && ((DUP_MASK >> 6) & 1)) ? 1 : 0);
        SEAM(6);
    }
    if (IN(7)) { LOAD_P(); REP(7) pm1_convert(T, P); SEAM(7); }
    if (IN(8)) { LOAD_P(); (void)P;
        SchedGen S{G, c, 64, 22, (const char*)hbX, (const char*)(ws + WS_WGU0), nullptr, nullptr, 524288, 0, 0, 524288, 0, 0};
        EpiGU<false> E{(bf16_t*)(ws + WS_HD), 2816, partB, nullptr, nullptr};
        REP(8) gemm_phase<EpiGU<false>, SchedGen, false, false>(lds, 1024, 1024, 16, 16, S, E, (rep_ == 0 && ((DUP_MASK >> 8) & 1)) ? 1 : 0);
        SEAM(8);
    }
    if (IN(9)) { LOAD_P(); (void)P;
        SchedGen S{G, c, 64, 4, (const char*)(ws + WS_HD), (const char*)(ws + WS_WD0), nullptr, nullptr, 1441792, 0, 0, 1441792, 0, 0};
        EpiRes<0> E{P.out, P.out, hbX, partA, nullptr, nullptr};
        REP(9) gemm_phase<EpiRes<0>, SchedGen, false, false>(lds, 2816, 2816, 44, 44, S, E, (rep_ == 0 && ((DUP_MASK >> 9) & 1)) ? 1 : 0);
        SEAM(9);
    }
    if (IN(10)) { LOAD_P(); (void)P;
        SchedGen S{G, c, 64, 4, (const char*)hbX, (const char*)(ws + WS_WPG0), nullptr, nullptr, 524288, 0, 0, 524288, 0, 0};
        EpiRes<1> E{P.out, P.out, hbY, partB, partA, (const bf16_t*)(ws + WS_U)};
        REP(10) gemm_phase<EpiRes<1>, SchedGen, false, false>(lds, 1024, 1024, 16, 16, S, E, (rep_ == 0 && ((DUP_MASK >> 10) & 1)) ? 1 : 0);
        SEAM(10);
    }
    if (IN(11)) { LOAD_P(); (void)P;
        SchedQKVB S{G, c, (const char*)hbY, (const char*)(ws + WS_WQKV)};
        EpiQKVB E{partB, (bf16_t*)(ws + WS_QB), (bf16_t*)(ws + WS_KB), (bf16_t*)(ws + WS_VBT)};
        REP(11) gemm_phase<EpiQKVB, SchedQKVB, false, false>(lds, 1024, 1024, 16, 16, S, E, (rep_ == 0 && ((DUP_MASK >> 11) & 1)) ? 1 : 0);
        SEAM(11);
    }
    if (IN(12)) { LOAD_P(); REP(12) attn_phase(T, P); SEAM(12); }
    if (IN(13)) { LOAD_P(); (void)P;
        SchedGen S{G, c, 64, 4, (const char*)(ws + WS_OB), (const char*)(ws + WS_WOB), nullptr, nullptr, 524288, 0, 0, 524288, 0, 0};
        EpiRes<0> E{P.out, P.out, nullptr, partA, nullptr, nullptr};
        REP(13) gemm_phase<EpiRes<0>, SchedGen, false, false>(lds, 1024, 1024, 16, 16, S, E, (rep_ == 0 && ((DUP_MASK >> 13) & 1)) ? 1 : 0);
        SEAM(13);
    }
    if (IN(14)) { LOAD_P(); t_router(T, P); SEAM(14); }
    if (IN(15)) { LOAD_P(); (void)P;
        SchedMoe S; S.G = G; S.c = c; S.nN = 28; S.init_counts((const unsigned*)(ws + WS_CTL) + CW_CNT);
        S.A = (const char*)(ws + WS_XS8); S.B = (const char*)(ws + WS_WGUM); S.b_e = 7340032; S.b_pn = 262144; S.a_rt = 0; S.a_e = 16777216; S.tok = nullptr;
        EpiGU<true> E{(bf16_t*)(ws + WS_HM), 3584, nullptr, (const float*)(ws + WS_MRS), (const float*)(ws + WS_MGW)};
        REP(15) gemm_phase<EpiGU<true>, SchedMoe, false, false, true>(lds, 512, 512, 8, 8, S, E, (rep_ == 0 && ((DUP_MASK >> 15) & 1)) ? 1 : 0);
        SEAM(15);
    }
    if (IN(16)) { LOAD_P(); (void)P;
        { SchedMoe S; S.G = G; S.c = c; S.nN = 4; S.init_counts((const unsigned*)(ws + WS_CTL) + CW_CNT);
          S.A = (const char*)(ws + WS_HM); S.B = (const char*)(ws + WS_WDM); S.b_e = 3670016; S.b_pn = 917504; S.a_rt = 917504; S.a_e = 0; S.tok = nullptr;
          EpiStore<false> E{(bf16_t*)(ws + WS_YM), 1024, 1.f / (F8_SH * F8_SW2)};
          REP(16) gemm_phase<EpiStore<false>, SchedMoe, false, false, true>(lds, 1792, 1792, 28, 28, S, E, (rep_ == 0 && ((DUP_MASK >> 16) & 1)) ? 1 : 0); }
        { SchedGen S{G, c, 64, 4, (const char*)(ws + WS_PB) + (size_t)M * 256 * 2, (const char*)(ws + WS_WPU1), nullptr, nullptr, 131072, 0, 0, 131072, 0, 0};
          EpiStore<false> E{(bf16_t*)(ws + WS_U), 1024, 1.f};
          gemm_phase<EpiStore<false>, SchedGen, false, false>(lds, 256, 256, 4, 4, S, E); }
        SEAM(16);
    }
    if (IN(17)) { LOAD_P(); t_combine(T, P, hbX, partB); SEAM(17); }
    if (IN(18)) { LOAD_P(); (void)P;
        SchedGen S{G, c, 64, 4, (const char*)hbX, (const char*)(ws + WS_WPG1), nullptr, nullptr, 524288, 0, 0, 524288, 0, 0};
        EpiRes<1> E{P.out, P.out, nullptr, partA, partB, (const bf16_t*)(ws + WS_U)};
        REP(18) gemm_phase<EpiRes<1>, SchedGen, false, false>(lds, 1024, 1024, 16, 16, S, E, (rep_ == 0 && ((DUP_MASK >> 18) & 1)) ? 1 : 0);
        SEAM(18);
    }
    if (IN(19)) { LOAD_P(); t_final(T, P, partA); }
#ifdef EXTRA_BARS
    for (int xb_ = 0; xb_ < EXTRA_BARS; ++xb_) xcd_barrier(bar);
#endif
#undef IN
#undef SEAM
}

static int g_grid = 0;
static bool setup_once() {
    if (g_grid) return g_grid > 0;
    int dev = 0, cus = 0, per_cu = 0;
    if (hipGetDevice(&dev) != hipSuccess || hipDeviceGetAttribute(&cus, hipDeviceAttributeMultiprocessorCount, dev) != hipSuccess) { fprintf(stderr, "setup: device query failed\n"); g_grid = -1; return false; }
    if (hipFuncSetAttribute((const void*)fwd, hipFuncAttributeMaxDynamicSharedMemorySize, LDS_BYTES) != hipSuccess) { fprintf(stderr, "setup: hipFuncSetAttribute failed\n"); g_grid = -1; return false; }
    if (hipOccupancyMaxActiveBlocksPerMultiprocessor(&per_cu, (const void*)fwd, 512, LDS_BYTES) != hipSuccess || per_cu < 1) fprintf(stderr, "setup: occupancy query says %d\n", per_cu);
    (void)hipGetLastError();
    g_grid = cus;
    return true;
}
static void fill_args(Args& a, void* const* d_in, float* out, unsigned char* ws) { for (int i = 0; i < 24; ++i) a.in[i] = d_in[i]; a.out = out; a.ws = ws; a.pad = 0; }
static void launch_phases(void* const* d_in, float* out, unsigned char* ws, hipStream_t st, int lo, int hi, int use_bar) {
    Args a{}; fill_args(a, d_in, out, ws); a.ph_lo = lo; a.ph_hi = hi; a.use_bar = use_bar;
    hipLaunchKernelGGL(fwd, dim3(g_grid), dim3(512), LDS_BYTES, st, a);
}
}
#if FX_MODE == 1
namespace dbg {
constexpr int NCHK = 24;
constexpr size_t SNAP_BASE = (size_t)DBG_SNAP_MIB << 20;
struct Chk { size_t off; int cols; };
__global__ void __launch_bounds__(256) k_snap(const void* src, int is_bf16, long s_row, long s_col, int cols, float* dst) {
    const long n = (long)1024 * cols;
    for (long i = (long)blockIdx.x * 256 + threadIdx.x; i < n; i += (long)gridDim.x * 256) {
        const long sr = i / cols, c = i % cols, r = sr * 16; const long e = r * s_row + c * s_col;
        float v; if (is_bf16) v = __uint_as_float((unsigned)((const unsigned short*)src)[e] << 16); else v = ((const float*)src)[e];
        dst[i] = v;
    }
}
__global__ void __launch_bounds__(256) k_cmp(const float* snap, int cols, const float* nvp, long n_row, int b, int mode, float scale, float* err) {
    const long n = (long)512 * cols; float e0 = 0.f, e1 = 0.f;
    for (long i = (long)blockIdx.x * 256 + threadIdx.x; i < n; i += (long)gridDim.x * 256) {
        const long sr = i / cols, c = i % cols, rl = sr * 16;
        float nvv = nvp[rl * n_row + c];
        if (mode == 1) { const int h = (int)(c >> 8); const float lg = log2f(1.0f - exp2f(-5.0f - (float)h)); nvv *= exp2f(-(float)((rl & 255) + 1) * lg); }
        else if (mode == 2) nvv = nvv / (1.f + __expf(-nvv));
        else if (mode == 3) nvv *= scale;
        const float f = snap[((long)b * 512 + sr) * cols + c], d = f - nvv;
        e0 += d * d; e1 += nvv * nvv;
    }
    for (int o = 1; o < 64; o <<= 1) { e0 += __shfl_xor(e0, o); e1 += __shfl_xor(e1, o); }
    if ((threadIdx.x & 63) == 0) { atomicAdd(err, e0); atomicAdd(err + 1, e1); }
}
struct UsedArr { int u[NCHK]; };
__global__ void __launch_bounds__(256) k_finalize(float* out, const float* err, UsedArr used, long n4) {
    float sc = 1.f;
    for (int k = 0; k < NCHK; ++k) if (used.u[k]) { const float e0 = err[2 * k], e1 = err[2 * k + 1]; const bool bad = !(e0 <= DBG_THR * e1); if (bad) { sc = 1.f + 0.1f * (float)(k + 1); break; } }
    for (long i = (long)blockIdx.x * 256 + threadIdx.x; i < n4; i += (long)gridDim.x * 256) { float4 v = ((float4*)out)[i]; v.x *= sc; v.y *= sc; v.z *= sc; v.w *= sc; ((float4*)out)[i] = v; }
}
static unsigned char* g_ws = nullptr; static float* g_err = nullptr; static size_t g_cur = 0;
static size_t g_off[NCHK]; static int g_cols[NCHK]; static int g_have[NCHK];
static void snap(hipStream_t st, int k, const void* src, int is_bf16, long s_row, long s_col, int cols) {
    g_off[k] = g_cur; g_cols[k] = cols; g_have[k] = 1; g_cur += (size_t)1024 * cols * 4;
    hipLaunchKernelGGL(k_snap, dim3(2048), dim3(256), 0, st, src, is_bf16, s_row, s_col, cols, (float*)(g_ws + SNAP_BASE + g_off[k]));
}
static void cmp(hipStream_t st, int k, const float* nvp, long n_row, int b, int mode, float scale) {
    if (!g_have[k]) return;
    hipLaunchKernelGGL(k_cmp, dim3(1024), dim3(256), 0, st, (const float*)(g_ws + SNAP_BASE + g_off[k]), g_cols[k], nvp, n_row, b, mode, scale, g_err + 2 * k);
}
static void hook(int pt, int b, const float* p, hipStream_t st) {
    switch (pt) {
    case 0: cmp(st, 0, p, 6144, b, 0, 1.f); cmp(st, 1, p + 1024, 6144, b, 1, 1.f); cmp(st, 2, p + 4096, 6144, b, 2, 1.f); cmp(st, 3, p + 1024, 6144, b, 1, 1.f); cmp(st, 4, p + 2048, 6144, b, 0, 1.f); break;
    case 1: cmp(st, 5, p, 2048, b, 0, 1.f); break;
    case 2: cmp(st, 6, p, 1024, b, 0, 1.f); break;
    case 3: cmp(st, 7, p, 1024, b, 0, 1.f); break;
    case 4: cmp(st, 8, p, 1024, b, 0, 1.f); break;
    case 5: cmp(st, 9, p + (size_t)8192 * 2048, 1024, b, 3, fx::C2Q); cmp(st, 10, p, 2048, b, 0, 1.f); cmp(st, 11, p + 1024, 2048, b, 0, 1.f); break;
    case 6: cmp(st, 12, p, 1024, b, 0, 1.f); break;
    case 7: cmp(st, 13, p, 1024, b, 0, 1.f); break;
    case 8: cmp(st, 14, p, 1024, b, 0, 1.f); break;
    case 9: cmp(st, 15, p, 1024, b, 0, 1.f); break;
    case 10: cmp(st, 16, p, 1024, b, 0, 1.f); break;
    default: break;
    }
}
}
#endif

extern "C" void kernel_launch(void* const* d_in, const int* in_sizes, int n_in, void* d_out, int out_size, void* d_ws, size_t ws_size, hipStream_t stream) {
    if (n_in != 24 || out_size != 2 * 8192 * 1024 || ws_size < fx::WS_END) { fprintf(stderr, "kernel_launch: unexpected shapes (n_in %d out %d ws %zu)\n", n_in, out_size, ws_size); return; }
    float* out = (float*)d_out; unsigned char* ws = (unsigned char*)d_ws;
#if FX_MODE == 0
    nv::forward(d_in, out, ws, stream);
#else
    if (!fx::setup_once()) return;
    (void)hipMemsetAsync(ws + fx::WS_CTL, 0, fx::CTL_ZERO_BYTES, stream);
#if FX_MODE == 3
    fx::launch_phases(d_in, out, ws, stream, 0, fx::NPH, 1);
#elif FX_MODE == 2
    for (int ph = 0; ph < fx::NPH; ++ph) fx::launch_phases(d_in, out, ws, stream, ph, ph + 1, 0);
#else
    using namespace fx;
    dbg::g_ws = ws; dbg::g_cur = 0; for (int k = 0; k < dbg::NCHK; ++k) dbg::g_have[k] = 0;
    dbg::g_err = (float*)(ws + dbg::SNAP_BASE - 4096);
    for (int ph = 0; ph < DBG_HI; ++ph) {
        if (DBG_SKIP7 && ph == 7) continue;
        launch_phases(d_in, out, ws, stream, ph, ph + 1, 0);
        if (DBG_SET == 0) {
            if (ph == 1) { dbg::snap(stream, 0, ws + WS_Q, 1, 1024, 1, 1024); dbg::snap(stream, 1, ws + WS_KP, 1, 1024, 1, 1024); dbg::snap(stream, 2, ws + WS_G, 1, 2048, 1, 2048);
                           dbg::snap(stream, 3, ws + WS_KT, 1, 1, 16384, 1024); dbg::snap(stream, 4, ws + WS_VT, 1, 1, 16384, 2048); }
            if (ph == 4) dbg::snap(stream, 5, ws + WS_O, 1, 2048, 1, 2048);
            if (ph == 6) dbg::snap(stream, 6, out, 0, 1024, 1, 1024);
        }
        if (DBG_SET == 2) {
            if (ph == 17) dbg::snap(stream, 14, out, 0, 1024, 1, 1024);
            if (ph == 18) dbg::snap(stream, 15, out, 0, 1024, 1, 1024);
            if (ph == 19) dbg::snap(stream, 16, out, 0, 1024, 1, 1024);
        }
        if (DBG_SET == 1) {
            if (ph == 6) dbg::snap(stream, 6, out, 0, 1024, 1, 1024);
            if (ph == 9) dbg::snap(stream, 7, out, 0, 1024, 1, 1024);
            if (ph == 10) dbg::snap(stream, 8, out, 0, 1024, 1, 1024);
            if (ph == 11) { dbg::snap(stream, 9, ws + WS_QB, 1, 1024, 1, 1024); dbg::snap(stream, 10, ws + WS_KB, 1, 1024, 1, 1024); dbg::snap(stream, 11, ws + WS_VBT, 1, 1, 16384, 1024); }
            if (ph == 12) dbg::snap(stream, 12, ws + WS_OB, 1, 1024, 1, 1024);
            if (ph == 13) dbg::snap(stream, 13, out, 0, 1024, 1, 1024);
        }
    }
    dbg::UsedArr used{}; for (int k = 0; k < dbg::NCHK; ++k) used.u[k] = dbg::g_have[k];
    (void)hipMemsetAsync(ws + dbg::SNAP_BASE - 4096, 0, 4096, stream);
    nv::g_hook = dbg::hook;
    nv::forward(d_in, out, ws, stream);
    hipLaunchKernelGGL(dbg::k_finalize, dim3(2048), dim3(256), 0, stream, out, (const float*)dbg::g_err, used, (long)2 * 8192 * 1024 / 4);
#endif
#endif
}
```

```cpp
#include <hip/hip_runtime.h>
#include <cstdio>
#include <cstdint>
#ifndef FX_MODE
#define FX_MODE 3
#endif
#ifndef T0_REPS
#define T0_REPS 2
#endif
#ifndef T0_SEL
#define T0_SEL 0xff
#endif
#define DUP_MASK 0

#define DBG_HI 20
#define DBG_SET 2
#define DBG_SKIP7 0
#define DBG_SNAP_MIB 380
#define DBG_THR 4e-4f
namespace nv {
static void (*g_hook)(int, int, const float*, hipStream_t) = nullptr;
#define NV_HOOK(pt, ptr) do { if (g_hook) g_hook((pt), b, (const float*)(ptr), st); } while (0)
constexpr int S = 8192, D = 1024, NB = 2;
constexpr int RQK = 1024, RV = 2048, DFF = 2816, NE = 8, DFE = 3584, PLE = 256;
constexpr float EPS = 1e-6f;

__device__ __forceinline__ float wave_sum(float v) {
#pragma unroll
    for (int o = 1; o < 64; o <<= 1) v += __shfl_xor(v, o);
    return v;
}
__device__ __forceinline__ float silu_f(float x) { return x / (1.f + __expf(-x)); }
__device__ __forceinline__ float sigmoid_f(float x) { return 1.f / (1.f + __expf(-x)); }

__global__ void __launch_bounds__(256) k_rmsnorm(const float* in, const float* __restrict__ gain, float* out, int rows) {
    const int row = blockIdx.x * 4 + (threadIdx.x >> 6), lane = threadIdx.x & 63;
    if (row >= rows) return;
    const float4* x = (const float4*)(in + (size_t)row * D);
    const float4* g = (const float4*)gain;
    float4 v[4]; float s = 0.f;
#pragma unroll
    for (int j = 0; j < 4; ++j) { v[j] = x[lane + 64 * j]; s += v[j].x * v[j].x + v[j].y * v[j].y + v[j].z * v[j].z + v[j].w * v[j].w; }
    s = wave_sum(s);
    const float r = rsqrtf(s * (1.f / D) + EPS);
    float4* o = (float4*)(out + (size_t)row * D);
#pragma unroll
    for (int j = 0; j < 4; ++j) { const float4 gg = g[lane + 64 * j]; o[lane + 64 * j] = make_float4(v[j].x * r * gg.x, v[j].y * r * gg.y, v[j].z * r * gg.z, v[j].w * r * gg.w); }
}

__global__ void __launch_bounds__(256) k_sgemm(const float* __restrict__ A, int lda, const int* __restrict__ idx, const float* __restrict__ B, int ldb,
                                               float* __restrict__ C, int ldc, int M, const int* __restrict__ cnt, int K, int accum) {
    __shared__ float As[16][68];
    __shared__ float Bs[16][64];
    const int Mv = cnt ? *cnt : M;
    const int m0 = blockIdx.y * 64, n0 = blockIdx.x * 64;
    if (m0 >= Mv) return;
    const int tid = threadIdx.x, tx = tid & 15, ty = tid >> 4;
    float c[4][4];
#pragma unroll
    for (int i = 0; i < 4; ++i)
#pragma unroll
        for (int j = 0; j < 4; ++j) c[i][j] = 0.f;
    const int ar = tid >> 2, ak = (tid & 3) * 4;
    const int arow = m0 + ar; const bool aval = arow < Mv;
    const int asrc = aval ? (idx ? idx[arow] : arow) : 0;
    const float* Ap = A + (size_t)asrc * lda + ak;
    const int bk = tid >> 4, bn = (tid & 15) * 4;
    const float* Bp = B + (size_t)bk * ldb + n0 + bn;
    for (int k0 = 0; k0 < K; k0 += 16) {
        float4 a = make_float4(0.f, 0.f, 0.f, 0.f);
        if (aval) a = *(const float4*)(Ap + k0);
        const float4 b = *(const float4*)(Bp + (size_t)k0 * ldb);
        __syncthreads();
        As[ak + 0][ar] = a.x; As[ak + 1][ar] = a.y; As[ak + 2][ar] = a.z; As[ak + 3][ar] = a.w;
        *(float4*)&Bs[bk][bn] = b;
        __syncthreads();
#pragma unroll
        for (int kk = 0; kk < 16; ++kk) {
            const float4 av = *(const float4*)&As[kk][ty * 4];
            const float4 bv = *(const float4*)&Bs[kk][tx * 4];
            const float aa[4] = {av.x, av.y, av.z, av.w}, bb[4] = {bv.x, bv.y, bv.z, bv.w};
#pragma unroll
            for (int i = 0; i < 4; ++i)
#pragma unroll
                for (int j = 0; j < 4; ++j) c[i][j] += aa[i] * bb[j];
        }
    }
#pragma unroll
    for (int i = 0; i < 4; ++i) {
        const int row = m0 + ty * 4 + i;
        if (row < Mv) {
            float4* cp = (float4*)(C + (size_t)row * ldc + n0 + tx * 4);
            float4 o = make_float4(c[i][0], c[i][1], c[i][2], c[i][3]);
            if (accum) { const float4 old = *cp; o.x += old.x; o.y += old.y; o.z += old.z; o.w += old.w; }
            *cp = o;
        }
    }
}

__global__ void __launch_bounds__(256) k_rotary(float* __restrict__ T, int ld, const int* __restrict__ pos, float scale, int rows) {
    const int g = blockIdx.x * 256 + threadIdx.x;
    if (g >= rows * 512) return;
    const int i = g & 127, h = (g >> 7) & 3, r = g >> 9;
    const float ex = (float)i / 127.0f;
    const float invf = (float)(1.0 / pow(10000.0, (double)ex));
    const float ang = (float)pos[r] * invf;
    double t = (double)ang * 0.15915494309189535;
    t -= rint(t);
    float sn, cs; sincospif(2.0f * (float)t, &sn, &cs);
    float* p = T + (size_t)r * ld + h * 256 + i;
    const float x1 = p[0], x2 = p[128];
    p[0] = (x1 * cs - x2 * sn) * scale;
    p[128] = (x1 * sn + x2 * cs) * scale;
}

__global__ void __launch_bounds__(256) k_retention(const float* __restrict__ q, const float* __restrict__ k, const float* __restrict__ v, int ld, float* __restrict__ o, int ntok) {
    const int w = blockIdx.x * 4 + (threadIdx.x >> 6), lane = threadIdx.x & 63;
    const int h = w >> 6, e = (w & 63) * 8 + (lane >> 3), part = lane & 7;
    const float gamma = 1.0f - exp2f(-5.0f - (float)h);
    float st[32];
#pragma unroll
    for (int d = 0; d < 32; ++d) st[d] = 0.f;
    const float* qp = q + h * 256 + part * 32; const float* kp = k + h * 256 + part * 32; const float* vp = v + h * 512 + e;
    float* op = o + h * 512 + e;
#pragma unroll 2
    for (int t = 0; t < ntok; ++t) {
        const float vv = vp[(size_t)t * ld];
        float dot = 0.f;
#pragma unroll
        for (int d4 = 0; d4 < 8; ++d4) {
            const float4 kk = *(const float4*)(kp + (size_t)t * ld + d4 * 4);
            const float4 qq = *(const float4*)(qp + (size_t)t * ld + d4 * 4);
            st[d4 * 4 + 0] = gamma * st[d4 * 4 + 0] + kk.x * vv; dot += qq.x * st[d4 * 4 + 0];
            st[d4 * 4 + 1] = gamma * st[d4 * 4 + 1] + kk.y * vv; dot += qq.y * st[d4 * 4 + 1];
            st[d4 * 4 + 2] = gamma * st[d4 * 4 + 2] + kk.z * vv; dot += qq.z * st[d4 * 4 + 2];
            st[d4 * 4 + 3] = gamma * st[d4 * 4 + 3] + kk.w * vv; dot += qq.w * st[d4 * 4 + 3];
        }
        dot += __shfl_xor(dot, 1); dot += __shfl_xor(dot, 2); dot += __shfl_xor(dot, 4);
        if (part == 0) op[(size_t)t * RV] = dot;
    }
}

__global__ void __launch_bounds__(256) k_gn_gate(float* __restrict__ o, const float* __restrict__ g, int ldg, const float* __restrict__ gn, int rows) {
    const int w = blockIdx.x * 4 + (threadIdx.x >> 6), lane = threadIdx.x & 63;
    if (w >= rows * 4) return;
    const int r = w >> 2, h = w & 3;
    float4* op = (float4*)(o + (size_t)r * RV + h * 512); const float4* gp = (const float4*)(g + (size_t)r * ldg + h * 512); const float4* nn = (const float4*)(gn + h * 512);
    float4 a = op[lane], b = op[lane + 64];
    float s = a.x * a.x + a.y * a.y + a.z * a.z + a.w * a.w + b.x * b.x + b.y * b.y + b.z * b.z + b.w * b.w;
    s = wave_sum(s);
    const float rr = rsqrtf(s * (1.f / 512.f) + EPS);
    const float4 g0 = gp[lane], g1 = gp[lane + 64], n0 = nn[lane], n1 = nn[lane + 64];
    op[lane] = make_float4(silu_f(g0.x) * a.x * rr * n0.x, silu_f(g0.y) * a.y * rr * n0.y, silu_f(g0.z) * a.z * rr * n0.z, silu_f(g0.w) * a.w * rr * n0.w);
    op[lane + 64] = make_float4(silu_f(g1.x) * b.x * rr * n1.x, silu_f(g1.y) * b.y * rr * n1.y, silu_f(g1.z) * b.z * rr * n1.z, silu_f(g1.w) * b.w * rr * n1.w);
}

__global__ void __launch_bounds__(256) k_swiglu(float* __restrict__ G, const float* __restrict__ U, int ld, int ncols, int rows, const int* __restrict__ cnt) {
    const int Mv = cnt ? *cnt : rows;
    const size_t n4 = (size_t)ncols / 4;
    for (size_t i = (size_t)blockIdx.x * 256 + threadIdx.x; i < (size_t)Mv * n4; i += (size_t)gridDim.x * 256) {
        const size_t r = i / n4, c = (i % n4) * 4;
        float4* gp = (float4*)(G + r * ld + c); const float4 u = *(const float4*)(U + r * ld + c); float4 g = *gp;
        *gp = make_float4(silu_f(g.x) * u.x, silu_f(g.y) * u.y, silu_f(g.z) * u.z, silu_f(g.w) * u.w);
    }
}
__global__ void __launch_bounds__(256) k_ple_add(float* __restrict__ h, const float* __restrict__ up, const float* __restrict__ gate, size_t n4) {
    for (size_t i = (size_t)blockIdx.x * 256 + threadIdx.x; i < n4; i += (size_t)gridDim.x * 256) {
        float4 hh = ((float4*)h)[i]; const float4 u = ((const float4*)up)[i], g = ((const float4*)gate)[i];
        hh.x += u.x * sigmoid_f(g.x); hh.y += u.y * sigmoid_f(g.y); hh.z += u.z * sigmoid_f(g.z); hh.w += u.w * sigmoid_f(g.w);
        ((float4*)h)[i] = hh;
    }
}

__global__ void __launch_bounds__(256) k_band_attn(const float* __restrict__ q, const float* __restrict__ kv, const float* __restrict__ rel, float* __restrict__ o) {
    __shared__ float Ks[64][65];
    __shared__ float Vs[64][65];
    __shared__ float tab[320];
    const int c = blockIdx.x, h = blockIdx.y, tid = threadIdx.x, i = tid >> 2, part = tid & 3;
    for (int t = tid; t < 320; t += 256) tab[t] = rel[h * 320 + t];
    float qr[64], acc[64];
    const float* qp = q + (size_t)(c * 64 + i) * D + h * 64;
#pragma unroll
    for (int d = 0; d < 64; ++d) { qr[d] = qp[d] * 0.125f; acc[d] = 0.f; }
    float mx = -INFINITY, l = 0.f;
    for (int jt = 0; jt < 9; ++jt) {
        const int kc = c - 8 + jt;
        if (kc < 0) continue;
        __syncthreads();
        for (int e = tid; e < 64 * 64; e += 256) { const int r = e >> 6, d = e & 63; const float* src = kv + (size_t)(kc * 64 + r) * 2048 + h * 64 + d; Ks[r][d] = src[0]; Vs[r][d] = src[1024]; }
        __syncthreads();
        for (int kk = 0; kk < 16; ++kk) {
            const int kr = part * 16 + kk;
            float s = 0.f;
#pragma unroll
            for (int d = 0; d < 64; ++d) s += qr[d] * Ks[kr][d];
            int dist = i - kr + 64 * (8 - jt);
            dist = dist < -63 ? -63 : (dist > 256 ? 256 : dist);
            s += tab[dist + 63];
            const float mn = fmaxf(mx, s);
            const float f = __expf(mx - mn), p = __expf(s - mn);
            l = l * f + p;
#pragma unroll
            for (int d = 0; d < 64; ++d) acc[d] = acc[d] * f + p * Vs[kr][d];
            mx = mn;
        }
    }
#pragma unroll
    for (int sft = 1; sft < 4; sft <<= 1) {
        const float mo = __shfl_xor(mx, sft), lo = __shfl_xor(l, sft);
        const float mn = fmaxf(mx, mo), f0 = __expf(mx - mn), f1 = __expf(mo - mn);
        l = l * f0 + lo * f1;
#pragma unroll
        for (int d = 0; d < 64; ++d) { const float ao = __shfl_xor(acc[d], sft); acc[d] = acc[d] * f0 + ao * f1; }
        mx = mn;
    }
    if (part == 0) {
        float* op = o + (size_t)(c * 64 + i) * D + h * 64; const float inv = 1.f / l;
#pragma unroll
        for (int d = 0; d < 64; ++d) op[d] = acc[d] * inv;
    }
}

__global__ void __launch_bounds__(256) k_router(const float* __restrict__ xn, const float* __restrict__ wr, int* __restrict__ cnt, int* __restrict__ lidx, float* __restrict__ lw, int rows) {
    const int row = blockIdx.x * 4 + (threadIdx.x >> 6), lane = threadIdx.x & 63;
    if (row >= rows) return;
    float lg[8];
#pragma unroll
    for (int e = 0; e < 8; ++e) lg[e] = 0.f;
    for (int j = 0; j < 16; ++j) {
        const int kx = lane + 64 * j; const float x = xn[(size_t)row * D + kx];
        const float4 w0 = *(const float4*)(wr + (size_t)kx * 8), w1 = *(const float4*)(wr + (size_t)kx * 8 + 4);
        lg[0] += x * w0.x; lg[1] += x * w0.y; lg[2] += x * w0.z; lg[3] += x * w0.w; lg[4] += x * w1.x; lg[5] += x * w1.y; lg[6] += x * w1.z; lg[7] += x * w1.w;
    }
#pragma unroll
    for (int e = 0; e < 8; ++e) lg[e] = wave_sum(lg[e]);
    if (lane == 0) {
        int e1 = 0; float v1 = lg[0];
#pragma unroll
        for (int e = 1; e < 8; ++e) if (lg[e] > v1) { v1 = lg[e]; e1 = e; }
        int e2 = -1; float v2 = -INFINITY;
#pragma unroll
        for (int e = 0; e < 8; ++e) if (e != e1 && lg[e] > v2) { v2 = lg[e]; e2 = e; }
        const float p2 = __expf(v2 - v1), w1 = 1.f / (1.f + p2), w2 = p2 / (1.f + p2);
        const int s1 = atomicAdd(&cnt[e1], 1); lidx[e1 * rows + s1] = row; lw[e1 * rows + s1] = w1;
        const int s2 = atomicAdd(&cnt[e2], 1); lidx[e2 * rows + s2] = row; lw[e2 * rows + s2] = w2;
    }
}
__global__ void __launch_bounds__(256) k_scatter_add(float* __restrict__ h, const float* __restrict__ Y, const int* __restrict__ idx, const float* __restrict__ w, const int* __restrict__ cnt) {
    const int m = blockIdx.x * 4 + (threadIdx.x >> 6), lane = threadIdx.x & 63;
    if (m >= *cnt) return;
    const float ww = w[m]; float4* hp = (float4*)(h + (size_t)idx[m] * D); const float4* yp = (const float4*)(Y + (size_t)m * D);
#pragma unroll
    for (int j = 0; j < 4; ++j) { float4 a = hp[lane + 64 * j]; const float4 y = yp[lane + 64 * j]; a.x += ww * y.x; a.y += ww * y.y; a.z += ww * y.z; a.w += ww * y.w; hp[lane + 64 * j] = a; }
}

static void sgemm(hipStream_t st, const float* A, int lda, const int* idx, const float* B, int ldb, float* C, int ldc, int M, const int* cnt, int N, int K, int accum) {
    hipLaunchKernelGGL(k_sgemm, dim3(N / 64, (M + 63) / 64), dim3(256), 0, st, A, lda, idx, B, ldb, C, ldc, M, cnt, K, accum);
}

static void forward(void* const* d_in, float* out, unsigned char* ws, hipStream_t st) {
    const float* x = (const float*)d_in[0]; const float* p = (const float*)d_in[1]; const int* positions = (const int*)d_in[2];
    const float* norm_mix = (const float*)d_in[3]; const float* norm_ffn = (const float*)d_in[4]; const float* norm_ple = (const float*)d_in[5];
    const float* w_in_a = (const float*)d_in[6]; const float* ret_gn = (const float*)d_in[7]; const float* w_out_a = (const float*)d_in[8];
    const float* norm_kv = (const float*)d_in[9]; const float* w_kv = (const float*)d_in[10]; const float* w_q_b = (const float*)d_in[11];
    const float* rel_bias = (const float*)d_in[12]; const float* w_out_b = (const float*)d_in[13];
    const float* w_gate_dense = (const float*)d_in[14]; const float* w_up_dense = (const float*)d_in[15]; const float* w_down_dense = (const float*)d_in[16];
    const float* w_router = (const float*)d_in[17]; const float* w_gate_moe = (const float*)d_in[18]; const float* w_up_moe = (const float*)d_in[19]; const float* w_down_moe = (const float*)d_in[20];
    const float* w_ple_up = (const float*)d_in[21]; const float* w_ple_gate = (const float*)d_in[22]; const float* norm_final = (const float*)d_in[23];
    hipMemcpyAsync(out, x, (size_t)NB * S * D * 4, hipMemcpyDeviceToDevice, st);
    const size_t X1 = (size_t)S * D * 4;
    int* cnt = (int*)ws;
    int* lidx = (int*)(ws + 4096);
    float* lw = (float*)(ws + 4096 + 8 * S * 4);
    unsigned char* base = ws + (1u << 20);
    float* xn = (float*)base;
    float* bufA = (float*)(base + X1);
    for (int b = 0; b < NB; ++b) {
        float* h = out + (size_t)b * S * D;
        const int* pos = positions + b * S;
        {
            float* proj = bufA;
            float* o = (float*)((unsigned char*)bufA + 6 * X1);
            hipLaunchKernelGGL(k_rmsnorm, dim3(S / 4), dim3(256), 0, st, (const float*)h, norm_mix, xn, S);
            sgemm(st, xn, D, nullptr, w_in_a, 6144, proj, 6144, S, nullptr, 6144, D, 0);
            hipLaunchKernelGGL(k_rotary, dim3(S * 512 / 256), dim3(256), 0, st, proj, 6144, pos, 1.0f, S);
            hipLaunchKernelGGL(k_rotary, dim3(S * 512 / 256), dim3(256), 0, st, proj + 1024, 6144, pos, 0.0625f, S);
            NV_HOOK(0, proj);
            hipLaunchKernelGGL(k_retention, dim3(64), dim3(256), 0, st, (const float*)proj, (const float*)(proj + 1024), (const float*)(proj + 2048), 6144, o, S);
            NV_HOOK(1, o);
            hipLaunchKernelGGL(k_gn_gate, dim3(S), dim3(256), 0, st, o, (const float*)(proj + 4096), 6144, ret_gn, S);
            sgemm(st, o, 2048, nullptr, w_out_a, D, h, D, S, nullptr, D, 2048, 1);
            NV_HOOK(2, h);
        }
        {
            float* G = bufA; float* U = G + (size_t)S * DFF;
            hipLaunchKernelGGL(k_rmsnorm, dim3(S / 4), dim3(256), 0, st, (const float*)h, norm_ffn, xn, S);
            sgemm(st, xn, D, nullptr, w_gate_dense, DFF, G, DFF, S, nullptr, DFF, D, 0);
            sgemm(st, xn, D, nullptr, w_up_dense, DFF, U, DFF, S, nullptr, DFF, D, 0);
            hipLaunchKernelGGL(k_swiglu, dim3(4096), dim3(256), 0, st, G, (const float*)U, DFF, DFF, S, nullptr);
            sgemm(st, G, DFF, nullptr, w_down_dense, D, h, D, S, nullptr, D, DFF, 1);
            NV_HOOK(3, h);
        }
        for (int layer = 0; layer < 2; ++layer) {
            if (layer == 1) {
                float* kvb = bufA; float* qb = kvb + (size_t)S * 2048; float* ob = qb + (size_t)S * D;
                hipLaunchKernelGGL(k_rmsnorm, dim3(S / 4), dim3(256), 0, st, (const float*)h, norm_kv, xn, S);
                sgemm(st, xn, D, nullptr, w_kv, 2048, kvb, 2048, S, nullptr, 2048, D, 0);
                hipLaunchKernelGGL(k_rmsnorm, dim3(S / 4), dim3(256), 0, st, (const float*)h, norm_mix + D, xn, S);
                sgemm(st, xn, D, nullptr, w_q_b, D, qb, D, S, nullptr, D, D, 0);
                NV_HOOK(5, kvb);
                hipLaunchKernelGGL(k_band_attn, dim3(S / 64, 16), dim3(256), 0, st, (const float*)qb, (const float*)kvb, rel_bias, ob);
                NV_HOOK(6, ob);
                sgemm(st, ob, D, nullptr, w_out_b, D, h, D, S, nullptr, D, D, 1);
                NV_HOOK(7, h);
                float* G = bufA; float* U = G + (size_t)S * DFE; float* Y = U + (size_t)S * DFE;
                hipLaunchKernelGGL(k_rmsnorm, dim3(S / 4), dim3(256), 0, st, (const float*)h, norm_ffn + D, xn, S);
                hipMemsetAsync(cnt, 0, 64, st);
                hipLaunchKernelGGL(k_router, dim3(S / 4), dim3(256), 0, st, (const float*)xn, w_router, cnt, lidx, lw, S);
                for (int e = 0; e < NE; ++e) {
                    const float* wg = w_gate_moe + (size_t)e * D * DFE; const float* wu = w_up_moe + (size_t)e * D * DFE; const float* wd = w_down_moe + (size_t)e * DFE * D;
                    sgemm(st, xn, D, lidx + e * S, wg, DFE, G, DFE, S, cnt + e, DFE, D, 0);
                    sgemm(st, xn, D, lidx + e * S, wu, DFE, U, DFE, S, cnt + e, DFE, D, 0);
                    hipLaunchKernelGGL(k_swiglu, dim3(4096), dim3(256), 0, st, G, (const float*)U, DFE, DFE, S, (const int*)(cnt + e));
                    sgemm(st, G, DFE, nullptr, wd, D, Y, D, S, cnt + e, D, DFE, 0);
                    hipLaunchKernelGGL(k_scatter_add, dim3(S / 4), dim3(256), 0, st, h, (const float*)Y, (const int*)(lidx + e * S), (const float*)(lw + e * S), (const int*)(cnt + e));
                }
            }
            if (layer == 1) NV_HOOK(8, h);
            float* up = bufA; float* gate = up + (size_t)S * D;
            const float* pl = p + ((size_t)layer * NB + b) * S * PLE;
            hipLaunchKernelGGL(k_rmsnorm, dim3(S / 4), dim3(256), 0, st, (const float*)h, norm_ple + layer * D, xn, S);
            sgemm(st, xn, D, nullptr, w_ple_gate + (size_t)layer * D * D, D, gate, D, S, nullptr, D, D, 0);
            sgemm(st, pl, PLE, nullptr, w_ple_up + (size_t)layer * PLE * D, D, up, D, S, nullptr, D, PLE, 0);
            hipLaunchKernelGGL(k_ple_add, dim3(4096), dim3(256), 0, st, h, (const float*)up, (const float*)gate, (size_t)S * D / 4);
            NV_HOOK(layer == 0 ? 4 : 9, h);
        }
        hipLaunchKernelGGL(k_rmsnorm, dim3(S / 4), dim3(256), 0, st, (const float*)h, norm_final, h, S);
        NV_HOOK(10, h);
    }
}
}

namespace fx {
#define LAS __attribute__((address_space(3)))
#define GAS __attribute__((address_space(1)))
typedef unsigned short bf16_t;
typedef short bf16x8 __attribute__((ext_vector_type(8)));
typedef float f32x4 __attribute__((ext_vector_type(4)));
typedef float f32x2 __attribute__((ext_vector_type(2)));
typedef float f32x16 __attribute__((ext_vector_type(16)));
typedef unsigned u32x4 __attribute__((ext_vector_type(4)));
typedef unsigned u32x2 __attribute__((ext_vector_type(2)));
typedef int v4i_t __attribute__((ext_vector_type(4)));
typedef int v8i_t __attribute__((ext_vector_type(8)));
typedef GAS unsigned gu32;
#define RLX_AGENT __ATOMIC_RELAXED, __HIP_MEMORY_SCOPE_AGENT

constexpr int M = 16384, SEQ = 8192, D = 1024;
constexpr float EPS = 1e-6f, LOG2E = 1.4426950408889634f;
constexpr float C2Q = 0.125f * LOG2E;

__device__ __forceinline__ unsigned cvt_pk_bf16(float lo, float hi) { unsigned r; asm volatile("v_cvt_pk_bf16_f32 %0, %1, %2" : "=v"(r) : "v"(lo), "v"(hi)); return r; }
__device__ __forceinline__ float bf_lo(unsigned w) { return __uint_as_float(w << 16); }
__device__ __forceinline__ float bf_hi(unsigned w) { return __uint_as_float(w & 0xffff0000u); }
__device__ __forceinline__ float fexp2(float x) { return __builtin_amdgcn_exp2f(x); }
__device__ __forceinline__ float frcp(float x) { return __builtin_amdgcn_rcpf(x); }
__device__ __forceinline__ float frsq(float x) { return __builtin_amdgcn_rsqf(x); }
__device__ __forceinline__ float sigmoid_f(float x) { return frcp(1.f + fexp2(-LOG2E * x)); }
__device__ __forceinline__ float silu_f(float x) { return x * sigmoid_f(x); }
__device__ __forceinline__ float wave_sum(float v) {
#pragma unroll
    for (int o = 1; o < 64; o <<= 1) v += __shfl_xor(v, o);
    return v;
}
__device__ __forceinline__ float lg2gamma(int h) { return __builtin_amdgcn_logf(1.0f - fexp2(-5.0f - (float)h)); }
__device__ __forceinline__ float sum16(const float* p) {
    const f32x4* q = (const f32x4*)p; const f32x4 a = q[0], b = q[1], c = q[2], d = q[3];
    return (((a[0] + a[1]) + (a[2] + a[3])) + ((b[0] + b[1]) + (b[2] + b[3]))) + (((c[0] + c[1]) + (c[2] + c[3])) + ((d[0] + d[1]) + (d[2] + d[3])));
}
__device__ __forceinline__ float rstd16(const float* part, int tok) { return frsq(sum16(part + (size_t)tok * 16) * (1.f / 1024.f) + EPS); }

constexpr int BM = 256, BK = 64, HALF = 128, HTB = HALF * BK * 2, STAGE_BYTES = 8 * HTB;
__host__ __device__ __forceinline__ int lds_byte(int r, int c) { const int st = (r >> 4) * 2 + (c >> 5), rr = r & 15, cc = c & 31, ob = rr * 64 + cc * 2; return st * 1024 + (ob ^ (((ob >> 9) & 1) << 5)); }
__host__ __device__ __forceinline__ void stage_rc(int b, int& R, int& C) { const int st = b / 1024, sb = b % 1024, swz = sb ^ (((sb >> 9) & 1) << 5); R = (st >> 1) * 16 + swz / 64; C = (st & 1) * 32 + (swz % 64) / 2; }
__host__ __device__ __forceinline__ int perm32(int rho) { const int n = rho >> 4, i = rho & 15; return 8 * (i >> 2) + 4 * n + (i & 3); }

struct Unit { int pm, pn, kind, ex, lim; };

__device__ __forceinline__ void lin_tile(int nM, int nN, int L, int& pm, int& pn) {
    const int nwg = nM * nN;
    int wgid = L; { const int q = nwg / 8, r = nwg % 8, xcd = wgid % 8, off = wgid / 8; wgid = (xcd < r ? xcd * (q + 1) : r * (q + 1) + (xcd - r) * q) + off; }
    const int nig = 8 * nN, gid = wgid / nig, fm = gid * 8, gsz = (nM - fm) < 8 ? (nM - fm) : 8;
    pm = fm + ((wgid % nig) % gsz); pn = (wgid % nig) / gsz;
}

template <class Epi, class Sched, bool SEG2, bool GATHER, bool FP8 = false>
__device__ __forceinline__ void gemm_phase(LAS unsigned char* lds, const int lda, const int ldb, const int nt_c, const int nt0, const Sched& S, const Epi& E, const int dry = 0) {
    int nt = nt_c; asm volatile("" : "+s"(nt));
    int tid_o = threadIdx.x; asm volatile("" : "+v"(tid_o));
    const int tid = tid_o, wid = __builtin_amdgcn_readfirstlane(tid >> 6), lane = tid & 63, wr = wid >> 2, wc = wid & 3, fr = lane & 15, fq = lane >> 4;
    unsigned voffA[2], voffB[2]; int RA[2], CA[2];
#pragma unroll
    for (int i = 0; i < 2; ++i) { int R, C; stage_rc(tid * 16 + i * 8192, R, C); const int Rb = Epi::PERM ? ((R & ~31) + perm32(R & 31)) : R;
        voffA[i] = (unsigned)(R * lda + C) * 2u; voffB[i] = (unsigned)(Rb * ldb + C) * 2u; RA[i] = R; CA[i] = C; }
    const size_t kstep = (size_t)(BK * 2);
    const size_t hstepA = (size_t)HALF * lda * 2, hstepB = (size_t)HALF * ldb * 2;
    const unsigned ldsw = (unsigned)wid * 1024u;
    const int aoff = lds_byte(wr * 64 + fr, fq * 8), boff = lds_byte(wc * 32 + fr, fq * 8);
#define FG_SA(b, h) (((b) * 2 + (h)) * HTB)
#define FG_SB(b, h) ((4 + (b) * 2 + (h)) * HTB)
#define FG_STAGE2(bufoff, gbase, o0, o1) do { \
        __builtin_amdgcn_global_load_lds((const unsigned*)((const char*)(gbase) + (o0)), (LAS unsigned*)(lds + (bufoff) + ldsw), 16, 0, 0); \
        __builtin_amdgcn_global_load_lds((const unsigned*)((const char*)(gbase) + (o1)), (LAS unsigned*)(lds + (bufoff) + ldsw + 8192), 16, 0, 0); } while (0)
#define FG_STB(bufoff, gbase) FG_STAGE2(bufoff, gbase, voffB[0], voffB[1])
#define FG_STA(bufoff, gbase, h, vg) do { if constexpr (GATHER) { FG_STAGE2(bufoff, gbase, vg[h][0], vg[h][1]); } else { FG_STAGE2(bufoff, (gbase) + (h) * hstepA, voffA[0], voffA[1]); } } while (0)
#define FG_LDA(dst, b, h) do { _Pragma("unroll") for (int m = 0; m < 4; ++m) _Pragma("unroll") for (int k = 0; k < 2; ++k) dst[m][k] = *(const LAS bf16x8*)(lds + FG_SA(b, h) + aoff + m * 2048 + k * 1024); } while (0)
#define FG_LD32(p) __builtin_shufflevector(*(const LAS v4i_t*)(p), *(const LAS v4i_t*)((p) + 1024), 0, 1, 2, 3, 4, 5, 6, 7)
#define FG_LDA8(dst, b, h) do { _Pragma("unroll") for (int m = 0; m < 4; ++m) dst[m] = FG_LD32(lds + FG_SA(b, h) + aoff + m * 2048); } while (0)
#define FG_LDB8(dst, b, h) do { _Pragma("unroll") for (int n = 0; n < 2; ++n) dst[n] = FG_LD32(lds + FG_SB(b, h) + boff + n * 2048); } while (0)
#define FG_LDB(dst, b, h) do { _Pragma("unroll") for (int n = 0; n < 2; ++n) _Pragma("unroll") for (int k = 0; k < 2; ++k) dst[n][k] = *(const LAS bf16x8*)(lds + FG_SB(b, h) + boff + n * 2048 + k * 1024); } while (0)
#define FG_CAT8(x) __builtin_shufflevector(__builtin_bit_cast(v4i_t, (x)[0]), __builtin_bit_cast(v4i_t, (x)[1]), 0, 1, 2, 3, 4, 5, 6, 7)
#define FG_RDA(b, h) do { if constexpr (FP8) FG_LDA8(At8, b, h); else FG_LDA(At, b, h); } while (0)
#define FG_RDB0(b, h) do { if constexpr (FP8) FG_LDB8(B08, b, h); else FG_LDB(B0, b, h); } while (0)
#define FG_RDB1(b, h) do { if constexpr (FP8) FG_LDB8(B18, b, h); else FG_LDB(B1, b, h); } while (0)
#define FG_MMA(ai, bj, At, Bt) do { __builtin_amdgcn_s_setprio(1); \
        if constexpr (FP8) { _Pragma("unroll") for (int m = 0; m < 4; ++m) _Pragma("unroll") for (int n = 0; n < 2; ++n) \
            asm volatile("v_mfma_scale_f32_16x16x128_f8f6f4 %0, %1, %2, %0, %3, %3 op_sel_hi:[0,0,0]" : "+v"(acc[ai][bj][m][n]) : "v"(Bt##8[n]), "v"(At##8[m]), "v"(sc_one)); } \
        else { _Pragma("unroll") for (int m = 0; m < 4; ++m) _Pragma("unroll") for (int n = 0; n < 2; ++n) _Pragma("unroll") for (int k = 0; k < 2; ++k) \
            acc[ai][bj][m][n] = __builtin_amdgcn_mfma_f32_16x16x32_bf16(Bt[n][k], At[m][k], acc[ai][bj][m][n], 0, 0, 0); } \
        __builtin_amdgcn_s_setprio(0); } while (0)
#define FG_WAIT_V(n) asm volatile("s_waitcnt vmcnt(" #n ")" ::: "memory")
#define FG_WAIT_L(n) asm volatile("s_waitcnt lgkmcnt(" #n ")" ::: "memory")
#define FG_BAR __builtin_amdgcn_s_barrier()
#define FG_SCHED __builtin_amdgcn_sched_barrier(0)
#define FG_KT(s0, d, t) ((s0) + (size_t)(t) * kstep + ((SEG2 && (t) >= nt0) ? (d) : 0l))
    Unit cur, nxt; int ui = 0;
    if (!S.next(0, cur)) return;
    f32x4 acc[2][2][4][2];
#pragma unroll
    for (int a = 0; a < 2; ++a)
#pragma unroll
        for (int b = 0; b < 2; ++b)
#pragma unroll
            for (int m = 0; m < 4; ++m)
#pragma unroll
                for (int n = 0; n < 2; ++n) acc[a][b][m][n] = (f32x4){0.f, 0.f, 0.f, 0.f};
    bf16x8 At[4][2], B0[2][2], B1[2][2]; v8i_t At8[4], B08[2], B18[2];
    int sc_one = 0x7f7f7f7f; asm volatile("" : "+v"(sc_one));
    const char* cA0 = S.pa(cur); const char* cB0 = S.pb(cur);
    long dA = 0, dB = 0;
    if constexpr (SEG2) { dA = S.dA() - (long)nt0 * (long)kstep; dB = S.dB() - (long)nt0 * (long)kstep; }
    unsigned vgc[2][2], vgn[2][2], vgs[2][2];
    if constexpr (GATHER) {
#pragma unroll
        for (int h = 0; h < 2; ++h)
#pragma unroll
            for (int i = 0; i < 2; ++i) { vgc[h][i] = (unsigned)(S.arow(cur, h * HALF + RA[i]) * lda + CA[i]) * 2u; vgn[h][i] = vgc[h][i]; vgs[h][i] = vgc[h][i]; }
    } else {
#pragma unroll
        for (int h = 0; h < 2; ++h)
#pragma unroll
            for (int i = 0; i < 2; ++i) { vgc[h][i] = 0u; vgn[h][i] = 0u; vgs[h][i] = 0u; }
    }
    FG_STB(FG_SB(0, 0), cB0); FG_STB(FG_SB(0, 1), cB0 + hstepB); FG_STA(FG_SA(0, 0), cA0, 0, vgc); FG_STA(FG_SA(0, 1), cA0, 1, vgc);
    if (wr == 1) FG_BAR;
    FG_WAIT_V(2); FG_BAR;
    FG_STB(FG_SB(1, 0), cB0 + kstep); FG_STA(FG_SA(1, 0), cA0 + kstep, 0, vgc); FG_STB(FG_SB(1, 1), cB0 + hstepB + kstep);
    FG_WAIT_V(6); FG_BAR;
    for (;;) {
        const bool has_next = S.next(ui + 1, nxt);
        const char* nA0 = has_next ? S.pa(nxt) : cA0; const char* nB0 = has_next ? S.pb(nxt) : cB0;
        if constexpr (GATHER) {
            if (has_next) {
#pragma unroll
                for (int h = 0; h < 2; ++h)
#pragma unroll
                    for (int i = 0; i < 2; ++i) vgn[h][i] = (unsigned)(S.arow(nxt, h * HALF + RA[i]) * lda + CA[i]) * 2u;
            }
        }
        for (int t = 0; t < nt; t += 2) {
            const bool last = (t == nt - 2);
            const char* a1 = FG_KT(cA0, dA, t + 1);
            const char* a2 = last ? nA0 : FG_KT(cA0, dA, t + 2); const char* b2 = last ? nB0 : FG_KT(cB0, dB, t + 2);
            const char* a3 = a2 + kstep; const char* b3 = b2 + kstep;
            if constexpr (GATHER) {
#pragma unroll
                for (int h = 0; h < 2; ++h)
#pragma unroll
                    for (int i = 0; i < 2; ++i) vgs[h][i] = last ? vgn[h][i] : vgc[h][i];
            }
            FG_RDB0(0, 0); FG_RDB1(0, 1); FG_SCHED; FG_RDA(0, 0); FG_STA(FG_SA(1, 1), a1, 1, vgc);
            FG_WAIT_V(8); FG_WAIT_L(0); FG_BAR; FG_MMA(0, 0, At, B0); FG_MMA(0, 1, At, B1); FG_BAR; FG_SCHED;
            FG_RDA(0, 1); FG_STB(FG_SB(0, 0), b2); FG_STB(FG_SB(0, 1), b2 + hstepB); FG_STA(FG_SA(0, 0), a2, 0, vgs);
            FG_WAIT_V(8); FG_WAIT_L(0); FG_BAR; FG_MMA(1, 0, At, B0); FG_MMA(1, 1, At, B1); FG_BAR; FG_SCHED;
            FG_RDB0(1, 0); FG_RDB1(1, 1); FG_SCHED; FG_RDA(1, 0); FG_STA(FG_SA(0, 1), a2, 1, vgs);
            FG_WAIT_V(8); FG_WAIT_L(0); FG_BAR; FG_MMA(0, 0, At, B0); FG_MMA(0, 1, At, B1); FG_BAR; FG_SCHED;
            FG_RDA(1, 1); FG_STB(FG_SB(1, 0), b3); FG_STB(FG_SB(1, 1), b3 + hstepB); FG_STA(FG_SA(1, 0), a3, 0, vgs);
            FG_WAIT_V(8); FG_WAIT_L(0); FG_BAR; FG_MMA(1, 0, At, B0); FG_MMA(1, 1, At, B1); FG_BAR; FG_SCHED;
        }
        if (wr == 0) FG_BAR;
        if constexpr (FP8) asm volatile("s_nop 15\n\ts_nop 15\n\ts_nop 15" ::: "memory");
        { int fr_o = fr, fq_o = fq; asm volatile("" : "+v"(fr_o), "+v"(fq_o));
          if (!dry) E(acc, cur, wr, wc, fr_o, fq_o); }
        if (!has_next) break;
#pragma unroll
        for (int a = 0; a < 2; ++a)
#pragma unroll
            for (int b = 0; b < 2; ++b)
#pragma unroll
                for (int m = 0; m < 4; ++m)
#pragma unroll
                    for (int n = 0; n < 2; ++n) acc[a][b][m][n] = (f32x4){0.f, 0.f, 0.f, 0.f};
        cur = nxt; cA0 = nA0; cB0 = nB0; ++ui;
        if constexpr (GATHER) {
#pragma unroll
            for (int h = 0; h < 2; ++h)
#pragma unroll
                for (int i = 0; i < 2; ++i) vgc[h][i] = vgn[h][i];
        }
        if (wr == 1) FG_BAR;
    }
    FG_WAIT_V(0);
    FG_BAR;
#undef FG_SA
#undef FG_SB
#undef FG_STAGE2
#undef FG_STB
#undef FG_STA
#undef FG_LDA
#undef FG_LDB
#undef FG_MMA
#undef FG_CAT8
#undef FG_LD32
#undef FG_LDA8
#undef FG_LDB8
#undef FG_RDA
#undef FG_RDB0
#undef FG_RDB1
#undef FG_WAIT_V
#undef FG_WAIT_L
#undef FG_BAR
#undef FG_SCHED
#undef FG_KT
}

struct SchedGen {
    int G, c, nM, nN; const char* A; const char* B; const char* A2; const char* B2; long a_pm, a_pn, b_pm, b_pn; int a_pn_shift, b_pm_shift; int pair;
    __device__ __forceinline__ bool next(int i, Unit& u) const {
        u.kind = 0; u.ex = 0; u.lim = 0;
        if (pair) { const long p = (long)(i >> 1) * G + c; const int hp = nN >> 1; if (p >= (long)nM * hp) return false; u.pm = (int)(p / hp); u.pn = (int)(p % hp) * 2 + (i & 1); return true; }
        const long L = (long)i * G + c; if (L >= (long)nM * nN) return false; lin_tile(nM, nN, (int)L, u.pm, u.pn); return true; }
    __device__ __forceinline__ long offa(const Unit& u) const { return (long)u.pm * a_pm + (long)(u.pn >> a_pn_shift) * a_pn; }
    __device__ __forceinline__ long offb(const Unit& u) const { return (long)(u.pm >> b_pm_shift) * b_pm + (long)u.pn * b_pn; }
    __device__ __forceinline__ const char* pa(const Unit& u) const { return A + offa(u); }
    __device__ __forceinline__ const char* pb(const Unit& u) const { return B + offb(u); }
    __device__ __forceinline__ long dA() const { return (long)(A2 - A); }
    __device__ __forceinline__ long dB() const { return (long)(B2 - B); }
    __device__ __forceinline__ int arow(const Unit&, int r) const { return r; }
};
struct SchedINA {
    int G, c; const char* hb; const char* W;
    __device__ __forceinline__ bool next(int i, Unit& u) const {
        long L = (long)i * G + c; u.ex = 0; u.lim = 0;
        if (L < 1024) { lin_tile(64, 16, (int)L, u.pm, u.pn); u.kind = u.pn < 4 ? 0 : (u.pn < 8 ? 1 : 2); return true; }
        L -= 1024; if (L >= 768) return false;
        lin_tile(12, 64, (int)L, u.pm, u.pn); u.kind = u.pm < 4 ? 3 : 4; return true;
    }
    __device__ __forceinline__ const char* pa(const Unit& u) const { return u.kind < 3 ? hb + (size_t)u.pm * (256 * 1024 * 2) : W + (size_t)(1024 + u.pm * 256) * 2048; }
    __device__ __forceinline__ const char* pb(const Unit& u) const { return u.kind < 3 ? W + (size_t)((u.pn < 8 ? u.pn : u.pn + 8) * 256) * 2048 : hb + (size_t)u.pn * (256 * 1024 * 2); }
    __device__ __forceinline__ long dA() const { return 0; }
    __device__ __forceinline__ long dB() const { return 0; }
    __device__ __forceinline__ int arow(const Unit&, int r) const { return r; }
};
struct SchedQKVB {
    int G, c; const char* hb; const char* W;
    __device__ __forceinline__ bool next(int i, Unit& u) const {
        long L = (long)i * G + c; u.ex = 0; u.lim = 0;
        if (L < 512) { lin_tile(64, 8, (int)L, u.pm, u.pn); u.kind = u.pn < 4 ? 0 : 1; return true; }
        L -= 512; if (L >= 256) return false;
        lin_tile(4, 64, (int)L, u.pm, u.pn); u.kind = 2; return true;
    }
    __device__ __forceinline__ const char* pa(const Unit& u) const { return u.kind < 2 ? hb + (size_t)u.pm * (256 * 1024 * 2) : W + (size_t)(2048 + u.pm * 256) * 2048; }
    __device__ __forceinline__ const char* pb(const Unit& u) const { return u.kind < 2 ? W + (size_t)(u.pn * 256) * 2048 : hb + (size_t)u.pn * (256 * 1024 * 2); }
    __device__ __forceinline__ long dA() const { return 0; }
    __device__ __forceinline__ long dB() const { return 0; }
    __device__ __forceinline__ int arow(const Unit&, int r) const { return r; }
};
struct SchedMoe {
    int G, c, nN; int c0, c1, c2, c3, c4, c5, c6, c7; int RT;
    const char* A; const char* B; long b_e, b_pn, a_rt, a_e; const int* tok;
    __device__ __forceinline__ void init_counts(const unsigned* cnt) {
        c0 = (int)cnt[0]; c1 = (int)cnt[1]; c2 = (int)cnt[2]; c3 = (int)cnt[3]; c4 = (int)cnt[4]; c5 = (int)cnt[5]; c6 = (int)cnt[6]; c7 = (int)cnt[7];
        RT = ((c0 + 255) >> 8) + ((c1 + 255) >> 8) + ((c2 + 255) >> 8) + ((c3 + 255) >> 8) + ((c4 + 255) >> 8) + ((c5 + 255) >> 8) + ((c6 + 255) >> 8) + ((c7 + 255) >> 8);
    }
    __device__ __forceinline__ bool next(int i, Unit& u) const {
        const long L = (long)i * G + c; if (L >= (long)RT * nN) return false;
        lin_tile(RT, nN, (int)L, u.pm, u.pn);
        int e = 0, base = 0, ce = c0, t = (c0 + 255) >> 8;
#define MOE_STEP(k, ck) if (u.pm >= t) { e = k; base = t; ce = ck; } t += (ck + 255) >> 8;
        MOE_STEP(1, c1) MOE_STEP(2, c2) MOE_STEP(3, c3) MOE_STEP(4, c4) MOE_STEP(5, c5) MOE_STEP(6, c6) MOE_STEP(7, c7)
#undef MOE_STEP
        u.kind = e; u.ex = u.pm - base; u.lim = ce - u.ex * 256; return true;
    }
    __device__ __forceinline__ const char* pa(const Unit& u) const { return A + (long)u.pm * a_rt + (long)u.kind * a_e + (long)u.ex * (a_e >> 6); }
    __device__ __forceinline__ const char* pb(const Unit& u) const { return B + (long)u.kind * b_e + (long)u.pn * b_pn; }
    __device__ __forceinline__ long dA() const { return 0; }
    __device__ __forceinline__ long dB() const { return 0; }
    __device__ __forceinline__ int arow(const Unit& u, int r) const { return r < u.lim ? tok[u.kind * 16384 + u.ex * 256 + r] : 0; }
};
#define EPI_ARGS const f32x4 (&acc)[2][2][4][2], const Unit& u, int wr, int wc, int fr, int fq
__device__ __forceinline__ u32x4 pack8(const float (&o)[8]) { u32x4 w; w.x = cvt_pk_bf16(o[0], o[1]); w.y = cvt_pk_bf16(o[2], o[3]); w.z = cvt_pk_bf16(o[4], o[5]); w.w = cvt_pk_bf16(o[6], o[7]); return w; }

__device__ __forceinline__ unsigned pk4_fp8(float a, float b, float c, float d) {
    a = __builtin_amdgcn_fmed3f(a, -448.f, 448.f); b = __builtin_amdgcn_fmed3f(b, -448.f, 448.f); c = __builtin_amdgcn_fmed3f(c, -448.f, 448.f); d = __builtin_amdgcn_fmed3f(d, -448.f, 448.f);
    int w = 0; w = __builtin_amdgcn_cvt_pk_fp8_f32(a, b, w, false); w = __builtin_amdgcn_cvt_pk_fp8_f32(c, d, w, true); return (unsigned)w; }
__device__ __forceinline__ u32x2 pack8_fp8(const float (&o)[8]) { u32x2 w; w.x = pk4_fp8(o[0], o[1], o[2], o[3]); w.y = pk4_fp8(o[4], o[5], o[6], o[7]); return w; }
constexpr float F8_SA = 4.f, F8_SW1 = 128.f, F8_SH = 16.f, F8_SW2 = 256.f;

struct EpiINA {
    static constexpr bool PERM = true;
    const float* rstd0; const f32x2* rope; bf16_t *Q, *Kp, *Gt, *KT, *VT;
    __device__ __forceinline__ void operator()(EPI_ARGS) const {
        if (u.kind <= 1) {
            const int h = u.kind == 0 ? u.pn : u.pn - 4; bf16_t* dst = u.kind == 0 ? Q : Kp; const float lg = lg2gamma(h);
#pragma unroll
            for (int ai = 0; ai < 2; ++ai)
#pragma unroll
                for (int m = 0; m < 4; ++m) {
                    const int tok = u.pm * 256 + ai * 128 + wr * 64 + m * 16 + fr;
                    float sc = rstd0[tok]; if (u.kind == 1) sc *= 0.0625f * fexp2(-(float)((tok & 255) + 1) * lg);
                    const int i0 = wc * 32 + fq * 8;
                    const f32x4* rp = (const f32x4*)(rope + (size_t)tok * 128 + i0);
                    f32x4 rr[4]; rr[0] = rp[0]; rr[1] = rp[1]; rr[2] = rp[2]; rr[3] = rp[3];
                    float o1[8], o2[8];
#pragma unroll
                    for (int n = 0; n < 2; ++n)
#pragma unroll
                        for (int j = 0; j < 4; ++j) { const int t = 4 * n + j; const float cs = rr[t >> 1][(t & 1) * 2], sn = rr[t >> 1][(t & 1) * 2 + 1];
                            const float x1 = acc[ai][0][m][n][j], x2 = acc[ai][1][m][n][j]; o1[t] = (x1 * cs - x2 * sn) * sc; o2[t] = (x1 * sn + x2 * cs) * sc; }
                    bf16_t* p = dst + (size_t)tok * 1024 + h * 256 + i0;
                    *(u32x4*)p = pack8(o1); *(u32x4*)(p + 128) = pack8(o2);
                }
        } else if (u.kind == 2) {
#pragma unroll
            for (int ai = 0; ai < 2; ++ai)
#pragma unroll
                for (int m = 0; m < 4; ++m) {
                    const int tok = u.pm * 256 + ai * 128 + wr * 64 + m * 16 + fr; const float rs = rstd0[tok];
#pragma unroll
                    for (int bj = 0; bj < 2; ++bj) { float o[8];
#pragma unroll
                        for (int n = 0; n < 2; ++n)
#pragma unroll
                            for (int j = 0; j < 4; ++j) o[4 * n + j] = silu_f(rs * acc[ai][bj][m][n][j]);
                        *(u32x4*)(Gt + (size_t)tok * 2048 + (u.pn - 8) * 256 + bj * 128 + wc * 32 + fq * 8) = pack8(o); }
                }
        } else if (u.kind == 3) {
            const int h = u.pm; const float lg = lg2gamma(h);
#pragma unroll
            for (int bj = 0; bj < 2; ++bj) {
                const int tok0 = u.pn * 256 + bj * 128 + wc * 32 + fq * 8; float sc[8];
#pragma unroll
                for (int t = 0; t < 8; ++t) sc[t] = rstd0[tok0 + t] * 0.0625f * fexp2(-(float)(((tok0 + t) & 255) + 1) * lg);
#pragma unroll
                for (int m = 0; m < 4; ++m) {
                    const int i = wr * 64 + m * 16 + fr; float o1[8], o2[8];
#pragma unroll
                    for (int n = 0; n < 2; ++n)
#pragma unroll
                        for (int j = 0; j < 4; ++j) { const int t = 4 * n + j; const f32x2 cs = rope[(size_t)(tok0 + t) * 128 + i];
                            const float x1 = acc[0][bj][m][n][j], x2 = acc[1][bj][m][n][j]; o1[t] = (x1 * cs[0] - x2 * cs[1]) * sc[t]; o2[t] = (x1 * cs[1] + x2 * cs[0]) * sc[t]; }
                    *(u32x4*)(KT + (size_t)(h * 256 + i) * M + tok0) = pack8(o1); *(u32x4*)(KT + (size_t)(h * 256 + 128 + i) * M + tok0) = pack8(o2);
                }
            }
        } else {
            const int vrow0 = (u.pm - 4) * 256;
#pragma unroll
            for (int bj = 0; bj < 2; ++bj) {
                const int tok0 = u.pn * 256 + bj * 128 + wc * 32 + fq * 8; float sc[8];
#pragma unroll
                for (int t = 0; t < 8; ++t) sc[t] = rstd0[tok0 + t];
#pragma unroll
                for (int ai = 0; ai < 2; ++ai)
#pragma unroll
                    for (int m = 0; m < 4; ++m) { float o[8];
#pragma unroll
                        for (int n = 0; n < 2; ++n)
#pragma unroll
                            for (int j = 0; j < 4; ++j) o[4 * n + j] = acc[ai][bj][m][n][j] * sc[4 * n + j];
                        *(u32x4*)(VT + (size_t)(vrow0 + ai * 128 + wr * 64 + m * 16 + fr) * M + tok0) = pack8(o); }
            }
        }
    }
};
template <bool CAUSAL> struct EpiStore {
    static constexpr bool PERM = true;
    bf16_t* O; int ld; float scale;
    __device__ __forceinline__ void operator()(EPI_ARGS) const {
#pragma unroll
        for (int ai = 0; ai < 2; ++ai)
#pragma unroll
            for (int m = 0; m < 4; ++m) {
                const int r = ai * 128 + wr * 64 + m * 16 + fr;
#pragma unroll
                for (int bj = 0; bj < 2; ++bj) { const int c0 = bj * 128 + wc * 32 + fq * 8; float o[8];
                    float fd = (float)(r - c0 + 1);
#pragma unroll
                    for (int n = 0; n < 2; ++n)
#pragma unroll
                        for (int j = 0; j < 4; ++j) { const int t = 4 * n + j; o[t] = acc[ai][bj][m][n][j] * (CAUSAL ? __builtin_amdgcn_fmed3f(fd - (float)t, 0.f, 1.f) : scale); }
                    *(u32x4*)(O + (size_t)(u.pm * 256 + r) * ld + u.pn * 256 + c0) = pack8(o); }
            }
    }
};
struct EpiR3 {
    static constexpr bool PERM = true;
    bf16_t* O; float* pgn;
    __device__ __forceinline__ void operator()(EPI_ARGS) const {
        const float lg = lg2gamma(u.pn >> 1);
#pragma unroll
        for (int ai = 0; ai < 2; ++ai)
#pragma unroll
            for (int m = 0; m < 4; ++m) {
                const int r = ai * 128 + wr * 64 + m * 16 + fr, tok = u.pm * 256 + r; const float xi = fexp2((float)(r + 1) * lg); float ss = 0.f;
#pragma unroll
                for (int bj = 0; bj < 2; ++bj) { float o[8];
#pragma unroll
                    for (int n = 0; n < 2; ++n)
#pragma unroll
                        for (int j = 0; j < 4; ++j) { const float v = acc[ai][bj][m][n][j] * xi; o[4 * n + j] = v; ss += v * v; }
                    *(u32x4*)(O + (size_t)tok * 2048 + u.pn * 256 + bj * 128 + wc * 32 + fq * 8) = pack8(o); }
                ss += __shfl_xor(ss, 16); ss += __shfl_xor(ss, 32);
                if (fq == 0) pgn[(size_t)tok * 32 + u.pn * 4 + wc] = ss;
            }
    }
};
template <int MODE> struct EpiRes {
    static constexpr bool PERM = false;
    const float* Hin; float* H; bf16_t* HB; float* pout; const float* pin; const bf16_t* U;
    __device__ __forceinline__ void operator()(EPI_ARGS) const {
#pragma unroll
        for (int ai = 0; ai < 2; ++ai)
#pragma unroll
            for (int m = 0; m < 4; ++m) {
                const int tok = u.pm * 256 + ai * 128 + wr * 64 + m * 16 + fr; float ss = 0.f; float rs = 1.f;
                if (MODE == 1) rs = rstd16(pin, tok);
#pragma unroll
                for (int bj = 0; bj < 2; ++bj)
#pragma unroll
                    for (int n = 0; n < 2; ++n) {
                        const size_t off = (size_t)tok * 1024 + u.pn * 256 + bj * 128 + wc * 32 + n * 16 + fq * 4;
                        f32x4 v = *(const f32x4*)(Hin + off); const f32x4 a = acc[ai][bj][m][n];
                        if (MODE == 1) { const u32x2 uu = *(const u32x2*)(U + off);
                            v[0] += bf_lo(uu.x) * sigmoid_f(rs * a[0]); v[1] += bf_hi(uu.x) * sigmoid_f(rs * a[1]); v[2] += bf_lo(uu.y) * sigmoid_f(rs * a[2]); v[3] += bf_hi(uu.y) * sigmoid_f(rs * a[3]);
                        } else v = v + a;
                        *(f32x4*)(H + off) = v; ss += (v[0] * v[0] + v[1] * v[1]) + (v[2] * v[2] + v[3] * v[3]);
                        if (HB) { u32x2 w; w.x = cvt_pk_bf16(v[0], v[1]); w.y = cvt_pk_bf16(v[2], v[3]); *(u32x2*)(HB + off) = w; }
                    }
                ss += __shfl_xor(ss, 16); ss += __shfl_xor(ss, 32);
                if (fq == 0) pout[(size_t)tok * 16 + u.pn * 4 + wc] = ss;
            }
    }
};
template <bool MOE> struct EpiGU {
    static constexpr bool PERM = true;
    bf16_t* Hd; int ld; const float* pin; const float* rsr; const float* gwr;
    __device__ __forceinline__ void operator()(EPI_ARGS) const {
#pragma unroll
        for (int ai = 0; ai < 2; ++ai)
#pragma unroll
            for (int m = 0; m < 4; ++m) {
                const int r = ai * 128 + wr * 64 + m * 16 + fr, row = u.pm * 256 + r; float rs, gw = 1.f; bool valid = true;
                if (MOE) { valid = r < u.lim; const int ix = u.kind * 16384 + u.ex * 256 + r; rs = valid ? rsr[ix] : 0.f; gw = valid ? gwr[ix] * F8_SH : 0.f; }
                else rs = rstd16(pin, row);
                float o[8];
                if (MOE) rs *= 1.f / (F8_SA * F8_SW1);
#pragma unroll
                for (int n = 0; n < 2; ++n)
#pragma unroll
                    for (int j = 0; j < 4; ++j) o[4 * n + j] = silu_f(rs * acc[ai][0][m][n][j]) * (rs * acc[ai][1][m][n][j]) * gw;
                if (MOE) { if (valid) *(u32x2*)((unsigned char*)Hd + (size_t)row * ld + u.pn * 128 + wc * 32 + fq * 8) = pack8_fp8(o); }
                else *(u32x4*)(Hd + (size_t)row * ld + u.pn * 128 + wc * 32 + fq * 8) = pack8(o);
            }
    }
};
struct EpiQKVB {
    static constexpr bool PERM = true;
    const float* pin; bf16_t *Qb, *Kb, *VbT;
    __device__ __forceinline__ void operator()(EPI_ARGS) const {
        if (u.kind < 2) {
            bf16_t* dst = u.kind == 0 ? Qb : Kb; const float s0 = u.kind == 0 ? C2Q : 1.f;
#pragma unroll
            for (int ai = 0; ai < 2; ++ai)
#pragma unroll
                for (int m = 0; m < 4; ++m) {
                    const int tok = u.pm * 256 + ai * 128 + wr * 64 + m * 16 + fr; const float rs = rstd16(pin, tok) * s0;
#pragma unroll
                    for (int bj = 0; bj < 2; ++bj) { float o[8];
#pragma unroll
                        for (int n = 0; n < 2; ++n)
#pragma unroll
                            for (int j = 0; j < 4; ++j) o[4 * n + j] = rs * acc[ai][bj][m][n][j];
                        *(u32x4*)(dst + (size_t)tok * 1024 + (u.pn & 3) * 256 + bj * 128 + wc * 32 + fq * 8) = pack8(o); }
                }
        } else {
#pragma unroll
            for (int bj = 0; bj < 2; ++bj) {
                const int tok0 = u.pn * 256 + bj * 128 + wc * 32 + fq * 8; float sc[8];
#pragma unroll
                for (int t = 0; t < 8; ++t) sc[t] = rstd16(pin, tok0 + t);
#pragma unroll
                for (int ai = 0; ai < 2; ++ai)
#pragma unroll
                    for (int m = 0; m < 4; ++m) { float o[8];
#pragma unroll
                        for (int n = 0; n < 2; ++n)
#pragma unroll
                            for (int j = 0; j < 4; ++j) o[4 * n + j] = acc[ai][bj][m][n][j] * sc[4 * n + j];
                        *(u32x4*)(VbT + (size_t)(u.pm * 256 + ai * 128 + wr * 64 + m * 16 + fr) * M + tok0) = pack8(o); }
            }
        }
    }
};

struct TCtx { LAS unsigned char* lds; int tid, lane, wave, vcu, G; };

__device__ __forceinline__ void cvt_item(const float* __restrict__ W, int N, const float* __restrict__ gain, bf16_t* __restrict__ dst, int dld, int mode, int row_off, LAS float* scr, int item, int lane) {
    const int nblk = N / 32, kb = item / nblk, nb = item % nblk, k0 = 64 * kb, n0 = 32 * nb;
    const bool hg = gain != nullptr; const float* gp = hg ? gain : W;
#pragma unroll 8
    for (int i = 0; i < 32; ++i) { const int kk = 2 * i + (lane >> 5); float v = W[(size_t)(k0 + kk) * N + n0 + (lane & 31)]; const float gv = gp[k0 + kk]; v *= hg ? gv : 1.f; scr[kk * 33 + (lane & 31)] = v; }
    asm volatile("s_waitcnt lgkmcnt(0)" ::: "memory");
    const int c = lane & 7;
#pragma unroll
    for (int j = 0; j < 4; ++j) { const int n = (lane >> 3) + 8 * j; const LAS float* s = scr + (8 * c) * 33 + n;
        u32x4 o; o.x = cvt_pk_bf16(s[0 * 33], s[1 * 33]); o.y = cvt_pk_bf16(s[2 * 33], s[3 * 33]); o.z = cvt_pk_bf16(s[4 * 33], s[5 * 33]); o.w = cvt_pk_bf16(s[6 * 33], s[7 * 33]);
        const int nn = n0 + n; const int drow = mode ? ((nn >> 7) << 8) + (nn & 127) + row_off : row_off + nn;
        *(u32x4*)(dst + (size_t)drow * dld + k0 + 8 * c) = o; }
    asm volatile("s_waitcnt lgkmcnt(0)" ::: "memory");
}
__device__ __forceinline__ void cvt_item8(const float* __restrict__ W, int N, const float* __restrict__ gain, float scale, unsigned char* __restrict__ dst, int dld, int mode, int row_off, LAS float* scr, int item, int lane) {
    const int nblk = N / 32, kb = item / nblk, nb = item % nblk, k0 = 64 * kb, n0 = 32 * nb;
    const bool hg = gain != nullptr; const float* gp = hg ? gain : W;
#pragma unroll 8
    for (int i = 0; i < 32; ++i) { const int kk = 2 * i + (lane >> 5); float v = W[(size_t)(k0 + kk) * N + n0 + (lane & 31)] * scale; const float gv = gp[k0 + kk]; v *= hg ? gv : 1.f; scr[kk * 33 + (lane & 31)] = v; }
    asm volatile("s_waitcnt lgkmcnt(0)" ::: "memory");
    const int c = lane & 7;
#pragma unroll
    for (int j = 0; j < 4; ++j) { const int n = (lane >> 3) + 8 * j; const LAS float* s = scr + (8 * c) * 33 + n;
        u32x2 o; o.x = pk4_fp8(s[0 * 33], s[1 * 33], s[2 * 33], s[3 * 33]); o.y = pk4_fp8(s[4 * 33], s[5 * 33], s[6 * 33], s[7 * 33]);
        const int nn = n0 + n; const int drow = mode ? ((nn >> 7) << 8) + (nn & 127) + row_off : row_off + nn;
        *(u32x2*)(dst + (size_t)drow * dld + k0 + 8 * c) = o; }
    asm volatile("s_waitcnt lgkmcnt(0)" ::: "memory");
}
struct CvtJob { const float* W; const float* gain; bf16_t* dst; int K, N, dld, mode, row_off; };
__device__ __forceinline__ int cvt_items(const CvtJob& j) { return (j.K / 64) * (j.N / 32); }
constexpr size_t MiB = 1u << 20;
constexpr size_t WS_CTL = 0, CTL_ZERO_BYTES = 1 * MiB;
constexpr size_t WS_PARTA = 1 * MiB, WS_PARTB = 2 * MiB, WS_PGN = 3 * MiB;
constexpr size_t WS_MTOK = 5 * MiB, WS_MRS = 5 * MiB + 512 * 1024, WS_MGW = 6 * MiB, WS_MSEL = 6 * MiB + 512 * 1024, WS_WRT = 6 * MiB + 768 * 1024, WS_RSTD0 = 7 * MiB;
constexpr size_t WS_WIN = 8 * MiB, WS_WOA = 20 * MiB, WS_WGU0 = 24 * MiB, WS_WD0 = 35 * MiB, WS_WPG0 = 41 * MiB, WS_WPG1 = 43 * MiB, WS_WPU0 = 45 * MiB, WS_WPU1 = 45 * MiB + 512 * 1024,
                 WS_WQKV = 46 * MiB, WS_WOB = 52 * MiB;
constexpr size_t WS_HBX = 56 * MiB, WS_PB = 88 * MiB, WS_U = 104 * MiB;
constexpr size_t WS_Q = 136 * MiB, WS_KP = 168 * MiB, WS_KT = 200 * MiB, WS_G = 232 * MiB, WS_VT = 296 * MiB, WS_PP = 360 * MiB, WS_UT = 392 * MiB, WS_ROPE = 456 * MiB, WS_ST = 168 * MiB;
constexpr size_t WS_O = WS_UT;
constexpr size_t WS_HD = 136 * MiB, WS_HBY = 264 * MiB, WS_WGUM = 411 * MiB, WS_WDM = 467 * MiB;
constexpr size_t WS_QB = 136 * MiB, WS_KB = 168 * MiB, WS_VBT = 200 * MiB, WS_OB = 232 * MiB;
constexpr size_t WS_HM = 136 * MiB, WS_YM = 264 * MiB, WS_XS8 = 264 * MiB, WS_END = 523 * MiB;
constexpr int CW_TMO = 0, CW_CNT = 64, CW_BAR = 4096;

#define CVT_TRY(Wp, gainp, dstp, K_, N_, dld_, mode_, roff_) { const int ni_ = ((K_) / 64) * ((N_) / 32); if (r < ni_) { cvt_item((Wp), (N_), (gainp), (dstp), (dld_), (mode_), (roff_), scr, r, T.lane); continue; } r -= ni_; }

struct Ptrs {
    const float *x, *p, *norm_mix, *norm_ffn, *norm_ple, *w_in_a, *ret_gn, *w_out_a, *norm_kv, *w_kv, *w_q_b, *rel_bias, *w_out_b, *w_gate_dense, *w_up_dense, *w_down_dense,
                *w_router, *w_gate_moe, *w_up_moe, *w_down_moe, *w_ple_up, *w_ple_gate, *norm_final;
    const int* positions; float* out; unsigned char* ws;
};

__device__ __forceinline__ void t0_prologue(const TCtx& T, const Ptrs& P, const int sel = 0xff) {
    unsigned char* ws = P.ws;
    LAS float* scr = (LAS float*)(T.lds + T.wave * 16384);
    const int gw = T.vcu * 8 + T.wave, NGW = T.G * 8;
    if (sel & 1) for (int it = gw; it < 16 * 192 + 32 * 32; it += NGW) {
        if (it < 16 * 192) cvt_item(P.w_in_a, 6144, P.norm_mix, (bf16_t*)(ws + WS_WIN), 1024, 0, 0, scr, it, T.lane);
        else cvt_item(P.w_out_a, 1024, P.ret_gn, (bf16_t*)(ws + WS_WOA), 2048, 0, 0, scr, it - 16 * 192, T.lane);
    }
    if (sel & 2) {
        bf16_t* hb = (bf16_t*)(ws + WS_HBX); float* rstd0 = (float*)(ws + WS_RSTD0);
        for (int m = gw; m < M; m += NGW) {
            const f32x4* xr = (const f32x4*)(P.x + (size_t)m * D) + T.lane; f32x4 v[4]; float s = 0.f;
#pragma unroll
            for (int j = 0; j < 4; ++j) { v[j] = xr[64 * j]; s += (v[j][0] * v[j][0] + v[j][1] * v[j][1]) + (v[j][2] * v[j][2] + v[j][3] * v[j][3]); }
            s = wave_sum(s);
            if (T.lane == 0) rstd0[m] = frsq(s * (1.f / 1024.f) + EPS);
            u32x2* o = (u32x2*)(hb + (size_t)m * D) + T.lane;
#pragma unroll
            for (int j = 0; j < 4; ++j) { u32x2 w; w.x = cvt_pk_bf16(v[j][0], v[j][1]); w.y = cvt_pk_bf16(v[j][2], v[j][3]); o[64 * j] = w; }
        }
    }
    const int gt = T.vcu * 512 + T.tid, NGT = T.G * 512;
    if (sel & 4) {
        bf16_t* pb = (bf16_t*)(ws + WS_PB);
        for (int i = gt; i < 2 * M * 256 / 8; i += NGT) { const f32x4 a = ((const f32x4*)P.p)[2 * i], b = ((const f32x4*)P.p)[2 * i + 1];
            u32x4 w; w.x = cvt_pk_bf16(a[0], a[1]); w.y = cvt_pk_bf16(a[2], a[3]); w.z = cvt_pk_bf16(b[0], b[1]); w.w = cvt_pk_bf16(b[2], b[3]); ((u32x4*)pb)[i] = w; }
    }
    {
        float* wrt = (float*)(ws + WS_WRT);
        for (int i = gt; i < 8192; i += NGT) { const int e = i >> 10, k = i & 1023; wrt[i] = P.w_router[k * 8 + e] * P.norm_ffn[1024 + k]; }
    }
    if (sel & 8) {
        LAS float* invf = (LAS float*)(T.lds + 12288);
        __syncthreads();
        if (T.tid < 128) { const float ex = (float)T.tid / 127.0f; invf[T.tid] = (float)(1.0 / pow(10000.0, (double)ex)); }
        __syncthreads();
        f32x2* rope = (f32x2*)(ws + WS_ROPE);
        for (int i = gt; i < M * 128; i += NGT) { const int tok = i >> 7, k = i & 127;
            const float ang = (float)P.positions[tok] * invf[k]; double t = (double)ang * 0.15915494309189535; t -= rint(t);
            const float tf = (float)t; rope[i] = (f32x2){__builtin_amdgcn_cosf(tf), __builtin_amdgcn_sinf(tf)}; }
    }
}
__device__ __forceinline__ void pm1_convert(const TCtx& T, const Ptrs& P) {
    LAS float* scr = (LAS float*)(T.lds + T.wave * 16384);
    const int gw = T.vcu * 8 + T.wave, NGW = T.G * 8;
    unsigned char* ws = P.ws;
    {
        constexpr int NIT = 2 * 16 * 88 + 44 * 32 + 2 * 16 * 32 + 2 * 4 * 32 + 16 * 64 + 16 * 32 + 16 * 32;
        for (int it = gw; it < NIT; it += NGW) {
            int r = it; const float* W = nullptr; const float* gn = nullptr; bf16_t* dst = nullptr; int N = 0, dld = 0, mode = 0, roff = 0; bool found = false;
#define CVT_PICK(Wp, gainp, dstp, K_, N_, dld_, mode_, roff_) { const int ni_ = ((K_) / 64) * ((N_) / 32); if (!found && r < ni_) { W = (Wp); gn = (gainp); dst = (dstp); N = (N_); dld = (dld_); mode = (mode_); roff = (roff_); found = true; } if (!found) r -= ni_; }
            CVT_PICK(P.w_gate_dense, P.norm_ffn, (bf16_t*)(ws + WS_WGU0), 1024, 2816, 1024, 1, 0)
            CVT_PICK(P.w_up_dense, P.norm_ffn, (bf16_t*)(ws + WS_WGU0), 1024, 2816, 1024, 1, 128)
            CVT_PICK(P.w_down_dense, (const float*)nullptr, (bf16_t*)(ws + WS_WD0), 2816, 1024, 2816, 0, 0)
            CVT_PICK(P.w_ple_gate, P.norm_ple, (bf16_t*)(ws + WS_WPG0), 1024, 1024, 1024, 0, 0)
            CVT_PICK(P.w_ple_gate + 1024 * 1024, P.norm_ple + 1024, (bf16_t*)(ws + WS_WPG1), 1024, 1024, 1024, 0, 0)
            CVT_PICK(P.w_ple_up, (const float*)nullptr, (bf16_t*)(ws + WS_WPU0), 256, 1024, 256, 0, 0)
            CVT_PICK(P.w_ple_up + 256 * 1024, (const float*)nullptr, (bf16_t*)(ws + WS_WPU1), 256, 1024, 256, 0, 0)
            CVT_PICK(P.w_q_b, P.norm_mix + 1024, (bf16_t*)(ws + WS_WQKV), 1024, 1024, 1024, 0, 0)
            CVT_PICK(P.w_kv, P.norm_kv, (bf16_t*)(ws + WS_WQKV), 1024, 2048, 1024, 0, 1024)
            CVT_PICK(P.w_out_b, (const float*)nullptr, (bf16_t*)(ws + WS_WOB), 1024, 1024, 1024, 0, 0)
#undef CVT_PICK
            cvt_item(W, N, gn, dst, dld, mode, roff, scr, r, T.lane);
        }
    }
    for (int it = gw; it < 8 * 3584 + 8 * 1792; it += NGW) {
        if (it < 8 * 3584) {
            const int e = it / 3584, q = it % 3584, which = q / 1792, item = q % 1792;
            cvt_item8((which ? P.w_up_moe : P.w_gate_moe) + (size_t)e * 1024 * 3584, 3584, P.norm_ffn + 1024, F8_SW1, P.ws + WS_WGUM + (size_t)e * 7168 * 1024, 1024, 1, which * 128, scr, item, T.lane);
        } else {
            const int r = it - 8 * 3584, e = r / 1792, item = r % 1792;
            cvt_item8(P.w_down_moe + (size_t)e * 3584 * 1024, 1024, (const float*)nullptr, F8_SW2, P.ws + WS_WDM + (size_t)e * 1024 * 3584, 3584, 0, 0, scr, item, T.lane);
        }
    }
}
__device__ __forceinline__ void t_scan(const TCtx& T, const Ptrs& P) {
    const bf16_t* UT = (const bf16_t*)(P.ws + WS_UT); bf16_t* ST = (bf16_t*)(P.ws + WS_ST);
    for (int g = T.vcu * 512 + T.tid; g < 2048 * 64; g += T.G * 512) {
        const int vrow = g >> 6, b = (g >> 5) & 1, d8 = g & 31;
        const float g256 = fexp2(256.0f * lg2gamma(vrow >> 9));
        float s[8];
#pragma unroll
        for (int k = 0; k < 8; ++k) s[k] = 0.f;
        const size_t base = (size_t)vrow * M + (size_t)b * SEQ + d8 * 8;
        for (int j0 = 0; j0 < 32; j0 += 8) {
            u32x4 uu[8];
#pragma unroll
            for (int j = 0; j < 8; ++j) uu[j] = *(const u32x4*)(UT + base + (j0 + j) * 256);
#pragma unroll
            for (int j = 0; j < 8; ++j) {
                *(u32x4*)(ST + base + (j0 + j) * 256) = pack8(s);
                s[0] = g256 * (s[0] + bf_lo(uu[j].x)); s[1] = g256 * (s[1] + bf_hi(uu[j].x)); s[2] = g256 * (s[2] + bf_lo(uu[j].y)); s[3] = g256 * (s[3] + bf_hi(uu[j].y));
                s[4] = g256 * (s[4] + bf_lo(uu[j].z)); s[5] = g256 * (s[5] + bf_hi(uu[j].z)); s[6] = g256 * (s[6] + bf_lo(uu[j].w)); s[7] = g256 * (s[7] + bf_hi(uu[j].w));
            }
        }
    }
}
__device__ __forceinline__ void t_gn_local(const TCtx& T, const Ptrs& P) {
    bf16_t* O = (bf16_t*)(P.ws + WS_O); const bf16_t* Gt = (const bf16_t*)(P.ws + WS_G); const float* pgn = (const float*)(P.ws + WS_PGN);
    for (int p = (int)blockIdx.x; p < 256; p += T.G) {
        const int rb = p >> 2, h = p & 3;
        for (int j0 = 0; j0 < 32; j0 += 4) {
            u32x4 ov[4], gv[4]; f32x4 pa[4], pb4[4];
#pragma unroll
            for (int j = 0; j < 4; ++j) { const int tok = rb * 256 + T.wave * 32 + j0 + j; const f32x4* pp = (const f32x4*)(pgn + (size_t)tok * 32 + h * 8); pa[j] = pp[0]; pb4[j] = pp[1];
                const size_t off = (size_t)tok * 2048 + h * 512 + T.lane * 8; ov[j] = *(const u32x4*)(O + off); gv[j] = *(const u32x4*)(Gt + off); }
#pragma unroll
            for (int j = 0; j < 4; ++j) { const int tok = rb * 256 + T.wave * 32 + j0 + j; const f32x4 a = pa[j], b = pb4[j];
                const float rs = frsq((((a[0] + a[1]) + (a[2] + a[3])) + ((b[0] + b[1]) + (b[2] + b[3]))) * (1.f / 512.f) + EPS);
                const size_t off = (size_t)tok * 2048 + h * 512 + T.lane * 8; float o[8];
                o[0] = bf_lo(ov[j].x) * bf_lo(gv[j].x) * rs; o[1] = bf_hi(ov[j].x) * bf_hi(gv[j].x) * rs; o[2] = bf_lo(ov[j].y) * bf_lo(gv[j].y) * rs; o[3] = bf_hi(ov[j].y) * bf_hi(gv[j].y) * rs;
                o[4] = bf_lo(ov[j].z) * bf_lo(gv[j].z) * rs; o[5] = bf_hi(ov[j].z) * bf_hi(gv[j].z) * rs; o[6] = bf_lo(ov[j].w) * bf_lo(gv[j].w) * rs; o[7] = bf_hi(ov[j].w) * bf_hi(gv[j].w) * rs;
                *(u32x4*)(O + off) = pack8(o); }
        }
    }
}
__device__ __forceinline__ void t_router(const TCtx& T, const Ptrs& P) {
    LAS float* wl = (LAS float*)T.lds;
    LAS int* se = (LAS int*)(T.lds + 32768);
    LAS float* sw = (LAS float*)(T.lds + 32768 + 512);
    const float* wrt = (const float*)(P.ws + WS_WRT);
    __syncthreads();
    for (int i = T.tid; i < 8192; i += 512) wl[i] = wrt[i];
    __syncthreads();
    unsigned* cnt = (unsigned*)(P.ws + WS_CTL) + CW_CNT;
    int* mtok = (int*)(P.ws + WS_MTOK); float* mrs = (float*)(P.ws + WS_MRS); float* mgw = (float*)(P.ws + WS_MGW); int* msel = (int*)(P.ws + WS_MSEL);
    for (int tb = T.vcu; tb < M / 64; tb += T.G) {
        for (int j = 0; j < 8; ++j) {
            const int lt = T.wave * 8 + j, tok = tb * 64 + lt;
            const f32x4* hr = (const f32x4*)(P.out + (size_t)tok * D) + T.lane; f32x4 v[4]; float ss = 0.f; float lg[8];
#pragma unroll
            for (int q = 0; q < 4; ++q) { v[q] = hr[64 * q]; ss += (v[q][0] * v[q][0] + v[q][1] * v[q][1]) + (v[q][2] * v[q][2] + v[q][3] * v[q][3]); }
#pragma unroll
            for (int e = 0; e < 8; ++e) { float a = 0.f;
#pragma unroll
                for (int q = 0; q < 4; ++q) { const f32x4 w = *(const LAS f32x4*)(wl + e * 1024 + 4 * (T.lane + 64 * q)); a += (v[q][0] * w[0] + v[q][1] * w[1]) + (v[q][2] * w[2] + v[q][3] * w[3]); }
                lg[e] = wave_sum(a); }
            ss = wave_sum(ss);
            if (T.lane == 0) {
                const float rs = frsq(ss * (1.f / 1024.f) + EPS);
                int e1 = 0; float v1 = lg[0];
#pragma unroll
                for (int e = 1; e < 8; ++e) if (lg[e] > v1) { v1 = lg[e]; e1 = e; }
                int e2 = 0; float v2 = -INFINITY;
#pragma unroll
                for (int e = 0; e < 8; ++e) if (e != e1 && lg[e] > v2) { v2 = lg[e]; e2 = e; }
                const float p2 = __expf((v2 - v1) * rs), w1 = 1.f / (1.f + p2), w2 = p2 / (1.f + p2);
                se[lt * 2] = e1; se[lt * 2 + 1] = e2; sw[lt * 3] = w1; sw[lt * 3 + 1] = w2; sw[lt * 3 + 2] = rs;
            }
        }
        __syncthreads();
        if (T.wave == 0) {
            const int e1 = se[T.lane * 2], e2 = se[T.lane * 2 + 1]; int r1 = 0, r2 = 0;
            const unsigned long long ltm = (1ull << T.lane) - 1ull;
#pragma unroll
            for (int e = 0; e < 8; ++e) {
                const unsigned long long m1 = __ballot(e1 == e), m2 = __ballot(e2 == e);
                const int n1 = __popcll(m1), n = n1 + __popcll(m2);
                unsigned base = 0u;
                if (T.lane == 0 && n > 0) base = __hip_atomic_fetch_add(cnt + e, (unsigned)n, RLX_AGENT);
                base = (unsigned)__builtin_amdgcn_readfirstlane((int)base);
                if (e1 == e) r1 = (int)base + __popcll(m1 & ltm);
                if (e2 == e) r2 = (int)base + n1 + __popcll(m2 & ltm);
            }
            const int tok = tb * 64 + T.lane; const float w1 = sw[T.lane * 3], w2 = sw[T.lane * 3 + 1], rs = sw[T.lane * 3 + 2];
            mtok[e1 * 16384 + r1] = tok; mrs[e1 * 16384 + r1] = rs; mgw[e1 * 16384 + r1] = w1;
            mtok[e2 * 16384 + r2] = tok; mrs[e2 * 16384 + r2] = rs; mgw[e2 * 16384 + r2] = w2;
            *(int4*)(msel + tok * 4) = make_int4(e1, r1, e2, r2);
            se[T.lane * 2] = e1 * 16384 + r1; se[T.lane * 2 + 1] = e2 * 16384 + r2;
        }
        __syncthreads();
        for (int j = 0; j < 8; ++j) {
            const int lt = T.wave * 8 + j, tok = tb * 64 + lt; const int d1 = se[lt * 2], d2 = se[lt * 2 + 1];
            const f32x4* hr = (const f32x4*)(P.out + (size_t)tok * D) + T.lane * 4; const f32x4 a = hr[0], b = hr[1], c = hr[2], d = hr[3];
            u32x4 w; w.x = pk4_fp8(F8_SA * a[0], F8_SA * a[1], F8_SA * a[2], F8_SA * a[3]); w.y = pk4_fp8(F8_SA * b[0], F8_SA * b[1], F8_SA * b[2], F8_SA * b[3]);
            w.z = pk4_fp8(F8_SA * c[0], F8_SA * c[1], F8_SA * c[2], F8_SA * c[3]); w.w = pk4_fp8(F8_SA * d[0], F8_SA * d[1], F8_SA * d[2], F8_SA * d[3]);
            unsigned char* xs = P.ws + WS_XS8;
            *(u32x4*)(xs + (size_t)d1 * 1024 + T.lane * 16) = w; *(u32x4*)(xs + (size_t)d2 * 1024 + T.lane * 16) = w;
        }
        __syncthreads();
    }
}
__device__ __forceinline__ void t_combine(const TCtx& T, const Ptrs& P, bf16_t* hb, float* pout) {
    const unsigned* cnt = (const unsigned*)(P.ws + WS_CTL) + CW_CNT; const int* msel = (const int*)(P.ws + WS_MSEL); const bf16_t* Y = (const bf16_t*)(P.ws + WS_YM);
    int tp[8]; { int t = 0;
#pragma unroll
        for (int e = 0; e < 8; ++e) { tp[e] = t; t += ((int)cnt[e] + 255) >> 8; } }
    for (int tok = T.vcu * 8 + T.wave; tok < M; tok += T.G * 8) {
        const int4 s4 = *(const int4*)(msel + tok * 4); int b1 = 0, b2 = 0;
#pragma unroll
        for (int e = 0; e < 8; ++e) { if (s4.x == e) b1 = tp[e]; if (s4.z == e) b2 = tp[e]; }
        const size_t s1 = (size_t)(b1 * 256 + s4.y), s2 = (size_t)(b2 * 256 + s4.w); float ss = 0.f;
#pragma unroll
        for (int q = 0; q < 2; ++q) {
            const int c0 = (T.lane + 64 * q) * 8; float* hp = P.out + (size_t)tok * D + c0;
            f32x4 a = *(const f32x4*)hp, b = *(const f32x4*)(hp + 4); const u32x4 y1 = *(const u32x4*)(Y + s1 * 1024 + c0), y2 = *(const u32x4*)(Y + s2 * 1024 + c0);
            a[0] += bf_lo(y1.x) + bf_lo(y2.x); a[1] += bf_hi(y1.x) + bf_hi(y2.x); a[2] += bf_lo(y1.y) + bf_lo(y2.y); a[3] += bf_hi(y1.y) + bf_hi(y2.y);
            b[0] += bf_lo(y1.z) + bf_lo(y2.z); b[1] += bf_hi(y1.z) + bf_hi(y2.z); b[2] += bf_lo(y1.w) + bf_lo(y2.w); b[3] += bf_hi(y1.w) + bf_hi(y2.w);
            *(f32x4*)hp = a; *(f32x4*)(hp + 4) = b;
            ss += ((a[0] * a[0] + a[1] * a[1]) + (a[2] * a[2] + a[3] * a[3])) + ((b[0] * b[0] + b[1] * b[1]) + (b[2] * b[2] + b[3] * b[3]));
            u32x4 w; w.x = cvt_pk_bf16(a[0], a[1]); w.y = cvt_pk_bf16(a[2], a[3]); w.z = cvt_pk_bf16(b[0], b[1]); w.w = cvt_pk_bf16(b[2], b[3]); *(u32x4*)(hb + (size_t)tok * D + c0) = w;
        }
        ss = wave_sum(ss);
        if (T.lane < 16) pout[(size_t)tok * 16 + T.lane] = T.lane == 0 ? ss : 0.f;
    }
}
__device__ __forceinline__ void t_final(const TCtx& T, const Ptrs& P, const float* pin, const float dsc, const float spike) {
    const f32x4* gg = (const f32x4*)P.norm_final + T.lane; f32x4 g[4];
#pragma unroll
    for (int q = 0; q < 4; ++q) g[q] = gg[64 * q];
    for (int tok0 = (T.vcu * 8 + T.wave) * 2; tok0 < M; tok0 += T.G * 16) {
        f32x4 v[2][4]; float rs[2];
#pragma unroll
        for (int j = 0; j < 2; ++j) { const f32x4* hr = (const f32x4*)(P.out + (size_t)(tok0 + j) * D) + T.lane;
#pragma unroll
            for (int q = 0; q < 4; ++q) v[j][q] = hr[64 * q];
            rs[j] = rstd16(pin, tok0 + j) * dsc; }
#pragma unroll
        for (int j = 0; j < 2; ++j) { f32x4* hr = (f32x4*)(P.out + (size_t)(tok0 + j) * D) + T.lane;
#pragma unroll
            for (int q = 0; q < 4; ++q) { f32x4 o = v[j][q] * rs[j]; o = o * g[q]; if (spike != 0.f && tok0 + j == 0 && q == 0 && T.lane == 0) o[0] = spike; hr[64 * q] = o; } }
    }
}

__device__ __forceinline__ int crow(int r, int hi) { return (r & 3) + 8 * (r >> 2) + 4 * hi; }
constexpr int AT_NS = 6, AT_PD = 5, AT_TAB = 24576, AT_STAGE = 16384;
__device__ __forceinline__ void attn_phase(const TCtx& T, const Ptrs& P) {
    const bf16_t* Qb = (const bf16_t*)(P.ws + WS_QB); const bf16_t* Kb = (const bf16_t*)(P.ws + WS_KB); const bf16_t* VbT = (const bf16_t*)(P.ws + WS_VBT); bf16_t* Ob = (bf16_t*)(P.ws + WS_OB);
    LAS float* tab = (LAS float*)T.lds;
    LAS unsigned char* ring = T.lds + AT_TAB;
    __syncthreads();
    for (int i = T.tid; i < 16 * 384; i += 512) { const int hh = i / 384, k = i % 384; tab[i] = P.rel_bias[hh * 320 + (k < 319 ? k : 319)] * LOG2E; }
    __syncthreads();
    const int l = T.lane & 31, hi = T.lane >> 5, w = T.wave;
    for (int unit = T.vcu; unit < 1024; unit += T.G) {
        const int b = unit >> 9, h = (unit >> 5) & 15, cq = unit & 31;
        const int c = 4 * cq + (w >> 1), half = w & 1;
        const int tokq = b * SEQ + c * 64 + half * 32 + l;
        bf16x8 qr[4];
#pragma unroll
        for (int d0 = 0; d0 < 4; ++d0) qr[d0] = *(const bf16x8*)(Qb + (size_t)tokq * D + h * 64 + 16 * d0 + 8 * hi);
        f32x16 o0 = {}, o1 = {}; float mrun = 0.f, lsum = 0.f; bool first = true;
        const LAS float* tb = tab + h * 384;
        const int iq = half * 32 + l;
        const int kc_lo = (4 * cq - 8) > 0 ? (4 * cq - 8) : 0, NT = 4 * cq + 4 - kc_lo;
        const bf16_t* ksrc = Kb + (size_t)(b * SEQ + kc_lo * 64 + T.lane) * D + h * 64 + 8 * w;
        const bf16_t* vsrc = VbT + (size_t)(h * 64 + T.lane) * M + b * SEQ + kc_lo * 64 + 8 * w;
#define AT_ISSUE(t_) do { const int st_ = (t_) % AT_NS; \
        __builtin_amdgcn_global_load_lds((const unsigned*)(ksrc + (size_t)(t_) * 64 * D), (LAS unsigned*)(ring + st_ * AT_STAGE + w * 1024), 16, 0, 0); \
        __builtin_amdgcn_global_load_lds((const unsigned*)(vsrc + (size_t)(t_) * 64), (LAS unsigned*)(ring + st_ * AT_STAGE + 8192 + w * 1024), 16, 0, 0); } while (0)
        for (int t = 0; t < AT_PD && t < NT; ++t) AT_ISSUE(t);
        for (int t = 0; t < NT; ++t) {
            const int rem = (NT - 1 - t) < (AT_PD - 1) ? (NT - 1 - t) : (AT_PD - 1);
            if (rem >= 4) asm volatile("s_waitcnt vmcnt(8)" ::: "memory");
            else if (rem == 3) asm volatile("s_waitcnt vmcnt(6)" ::: "memory");
            else if (rem == 2) asm volatile("s_waitcnt vmcnt(4)" ::: "memory");
            else if (rem == 1) asm volatile("s_waitcnt vmcnt(2)" ::: "memory");
            else asm volatile("s_waitcnt vmcnt(0)" ::: "memory");
            __builtin_amdgcn_s_barrier(); asm volatile("" ::: "memory");
            if (t + AT_PD < NT) AT_ISSUE(t + AT_PD);
            const int kc = kc_lo + t, jt = kc - (c - 8);
            if (jt >= 0 && jt <= 8) {
                const LAS unsigned char* ks = ring + (t % AT_NS) * AT_STAGE; const LAS unsigned char* vs = ks + 8192;
                f32x16 s0, s1;
                if (jt <= 3) { const float ci = tb[319] - mrun;
#pragma unroll
                    for (int r = 0; r < 16; ++r) { s0[r] = ci; s1[r] = ci; }
                } else {
                    const LAS float* pb = tb + (iq + 64 * (8 - jt) - 4 * hi);
#pragma unroll
                    for (int r = 0; r < 16; ++r) { s0[r] = pb[63 - ((r & 3) + 8 * (r >> 2))] - mrun; s1[r] = pb[31 - ((r & 3) + 8 * (r >> 2))] - mrun; }
                }
#pragma unroll
                for (int d0 = 0; d0 < 4; ++d0) {
                    const bf16x8 k0 = *(const LAS bf16x8*)(ks + ((2 * d0 + hi) * 64 + l) * 16), k1 = *(const LAS bf16x8*)(ks + ((2 * d0 + hi) * 64 + 32 + l) * 16);
                    s0 = __builtin_amdgcn_mfma_f32_32x32x16_bf16(k0, qr[d0], s0, 0, 0, 0); s1 = __builtin_amdgcn_mfma_f32_32x32x16_bf16(k1, qr[d0], s1, 0, 0, 0);
                }
                float mx = fmaxf(s0[0], s1[0]);
#pragma unroll
                for (int r = 1; r < 16; ++r) mx = fmaxf(fmaxf(mx, s0[r]), s1[r]);
                mx = fmaxf(mx, __shfl_xor(mx, 32));
                if (first || __any(mx > 8.0f)) {
                    const float dl = first ? mx : fmaxf(mx, 0.f), f = first ? 1.f : fexp2(-dl); mrun += dl; lsum *= f;
#pragma unroll
                    for (int r = 0; r < 16; ++r) { s0[r] -= dl; s1[r] -= dl; o0[r] *= f; o1[r] *= f; }
                    first = false;
                }
                float ps = 0.f;
#pragma unroll
                for (int r = 0; r < 16; ++r) { s0[r] = fexp2(s0[r]); s1[r] = fexp2(s1[r]); ps += s0[r] + s1[r]; }
                lsum += ps;
#pragma unroll
                for (int s4 = 0; s4 < 4; ++s4) {
                    u32x4 pw;
                    if (s4 < 2) { pw.x = cvt_pk_bf16(s0[8 * s4 + 0], s0[8 * s4 + 1]); pw.y = cvt_pk_bf16(s0[8 * s4 + 2], s0[8 * s4 + 3]); pw.z = cvt_pk_bf16(s0[8 * s4 + 4], s0[8 * s4 + 5]); pw.w = cvt_pk_bf16(s0[8 * s4 + 6], s0[8 * s4 + 7]); }
                    else { const int k2 = s4 - 2; pw.x = cvt_pk_bf16(s1[8 * k2 + 0], s1[8 * k2 + 1]); pw.y = cvt_pk_bf16(s1[8 * k2 + 2], s1[8 * k2 + 3]); pw.z = cvt_pk_bf16(s1[8 * k2 + 4], s1[8 * k2 + 5]); pw.w = cvt_pk_bf16(s1[8 * k2 + 6], s1[8 * k2 + 7]); }
                    const bf16x8 pf = __builtin_bit_cast(bf16x8, pw);
#pragma unroll
                    for (int db = 0; db < 2; ++db) {
                        const u32x2 va = *(const LAS u32x2*)(vs + ((2 * s4) * 64 + 32 * db + l) * 16 + 8 * hi), vb = *(const LAS u32x2*)(vs + ((2 * s4 + 1) * 64 + 32 * db + l) * 16 + 8 * hi);
                        const u32x4 vw = {va.x, va.y, vb.x, vb.y};
                        if (db == 0) o0 = __builtin_amdgcn_mfma_f32_32x32x16_bf16(__builtin_bit_cast(bf16x8, vw), pf, o0, 0, 0, 0);
                        else o1 = __builtin_amdgcn_mfma_f32_32x32x16_bf16(__builtin_bit_cast(bf16x8, vw), pf, o1, 0, 0, 0);
                    }
                }
            }
        }
#undef AT_ISSUE
        lsum += __shfl_xor(lsum, 32);
        const float inv = frcp(lsum);
        bf16_t* op = Ob + (size_t)tokq * D + h * 64 + 4 * hi;
#pragma unroll
        for (int g4 = 0; g4 < 4; ++g4) {
            u32x2 w0, w1; w0.x = cvt_pk_bf16(o0[4 * g4] * inv, o0[4 * g4 + 1] * inv); w0.y = cvt_pk_bf16(o0[4 * g4 + 2] * inv, o0[4 * g4 + 3] * inv);
            w1.x = cvt_pk_bf16(o1[4 * g4] * inv, o1[4 * g4 + 1] * inv); w1.y = cvt_pk_bf16(o1[4 * g4 + 2] * inv, o1[4 * g4 + 3] * inv);
            *(u32x2*)(op + 8 * g4) = w0; *(u32x2*)(op + 32 + 8 * g4) = w1;
        }
        asm volatile("s_waitcnt vmcnt(0) lgkmcnt(0)" ::: "memory"); __builtin_amdgcn_s_barrier(); asm volatile("" ::: "memory");
    }
}
#define XB_TMO      128
#define XB_XCNT(j)  (256  + 64 * (j))
#define XB_XSUB(j)  (1280 + 64 * (j))
#define XB_XGEN(j)  (2304 + 64 * (j))
#define XB_TOP      3328
#define XB_TOPGEN   3392
#define XCD_BAR_WORDS 3456
#define XB_SPIN_CAP (1u << 18)

__device__ __forceinline__ unsigned xb_ld(unsigned* p)              { return __hip_atomic_load(p, __ATOMIC_RELAXED, __HIP_MEMORY_SCOPE_AGENT); }
__device__ __forceinline__ unsigned xb_add(unsigned* p, unsigned v) { return __hip_atomic_fetch_add(p, v, __ATOMIC_RELAXED, __HIP_MEMORY_SCOPE_AGENT); }
__device__ __forceinline__ unsigned xb_xcc_id() { return (unsigned)__builtin_amdgcn_s_getreg((3 << 11) | 20) & 0xFu; }
#define XB_SPIN(cond, bar) do { unsigned _sp = 0; while (cond) { __builtin_amdgcn_s_sleep(1); \
    if ((++_sp & 255u) == 0u) { if (xb_ld(&(bar)[XB_TMO])) break; if (_sp > XB_SPIN_CAP) { atomicAdd(&(bar)[XB_TMO], 1u); break; } } } } while (0)

struct XcdBarrier {
    unsigned* bar; unsigned x;
    volatile LAS unsigned* st;
};

__device__ __forceinline__ XcdBarrier xcd_barrier_post(unsigned* bar, volatile LAS unsigned* st) {
    XcdBarrier b; b.bar = bar; b.x = xb_xcc_id(); b.st = st;
    if (threadIdx.x == 0) (void)xb_add(&bar[XB_XCNT(b.x)], 1u);
    return b;
}
__device__ __forceinline__ void xcd_barrier_complete(unsigned* bar, unsigned x, unsigned& nloc, unsigned& nx) {
    const unsigned G = gridDim.x * gridDim.y * gridDim.z;
    unsigned sum, cnt, mine, sp = 0u;
    for (;;) {
        sum = 0u; cnt = 0u; mine = 0u;
#pragma unroll
        for (unsigned j = 0; j < 16; ++j) { const unsigned c = xb_ld(&bar[XB_XCNT(j)]); sum += c; cnt += (c > 0u) ? 1u : 0u; mine = (j == x) ? c : mine; }
        if (sum == G) break;
        __builtin_amdgcn_s_sleep(1);
        if ((++sp & 255u) == 0u) { if (xb_ld(&bar[XB_TMO])) break; if (sp > XB_SPIN_CAP) { atomicAdd(&bar[XB_TMO], 1u); break; } }
    }
    nloc = mine > 0u ? mine : 1u; nx = cnt > 0u ? cnt : 1u;
}

__device__ __forceinline__ void xcd_barrier(const XcdBarrier& b) {
    asm volatile("s_waitcnt vmcnt(0)" ::: "memory");
    __syncthreads();
    if (threadIdx.x == 0) {
        unsigned* bar = b.bar;
        __builtin_amdgcn_s_waitcnt(0);
        unsigned nloc = b.st[0], nx = b.st[1];
        if (nloc == 0u) { xcd_barrier_complete(bar, b.x, nloc, nx); b.st[0] = nloc; b.st[1] = nx; }
        const unsigned old = xb_add(&bar[XB_XSUB(b.x)], 1u);
        const unsigned gen = old / nloc;
        if (old + 1u == (gen + 1u) * nloc) {
            __builtin_amdgcn_fence(__ATOMIC_RELEASE, "agent");
            asm volatile("s_waitcnt vmcnt(0)" ::: "memory");
            const unsigned og = xb_add(&bar[XB_TOP], 1u);
            const unsigned tg = og / nx;
            if (og + 1u == (tg + 1u) * nx) xb_add(&bar[XB_TOPGEN], 1u);
            else XB_SPIN(xb_ld(&bar[XB_TOPGEN]) == tg, bar);
            __builtin_amdgcn_fence(__ATOMIC_ACQUIRE, "agent");
            xb_add(&bar[XB_XGEN(b.x)], 1u);
            asm volatile("s_waitcnt vmcnt(0)" ::: "memory");
        } else {
            XB_SPIN(xb_ld(&bar[XB_XGEN(b.x)]) == gen, bar);
            __builtin_amdgcn_fence(__ATOMIC_ACQUIRE, "agent");
            asm volatile("s_waitcnt vmcnt(0)" ::: "memory");
        }
    }
    __syncthreads();
}

constexpr int LDS_RING = 131072, LDS_MISC = LDS_RING, LDS_BYTES = 147456;
constexpr int NPH = 19;
struct Args { const void* in[24]; float* out; unsigned char* ws; int ph_lo, ph_hi, use_bar, pad; };

__global__ void __launch_bounds__(512, 2) fwd(Args a) {
    extern __shared__ __attribute__((aligned(16))) unsigned char lds_raw[];
    LAS unsigned char* lds = (LAS unsigned char*)lds_raw;
    TCtx T; T.lds = lds; T.tid = threadIdx.x; T.lane = T.tid & 63; T.wave = __builtin_amdgcn_readfirstlane(T.tid >> 6); T.G = gridDim.x;
    { const int bx = blockIdx.x; T.vcu = (T.G % 8 == 0) ? (bx % 8) * (T.G / 8) + bx / 8 : bx; }
    typedef const Args __attribute__((address_space(4))) CArgs;
    CArgs* ap = (CArgs*)__builtin_amdgcn_kernarg_segment_ptr();
#define LOAD_P() Ptrs P; { asm volatile("" : "+s"(ap)); \
    P.x = (const float*)ap->in[0]; P.p = (const float*)ap->in[1]; P.positions = (const int*)ap->in[2]; P.norm_mix = (const float*)ap->in[3]; P.norm_ffn = (const float*)ap->in[4]; P.norm_ple = (const float*)ap->in[5]; \
    P.w_in_a = (const float*)ap->in[6]; P.ret_gn = (const float*)ap->in[7]; P.w_out_a = (const float*)ap->in[8]; P.norm_kv = (const float*)ap->in[9]; P.w_kv = (const float*)ap->in[10]; P.w_q_b = (const float*)ap->in[11]; \
    P.rel_bias = (const float*)ap->in[12]; P.w_out_b = (const float*)ap->in[13]; P.w_gate_dense = (const float*)ap->in[14]; P.w_up_dense = (const float*)ap->in[15]; P.w_down_dense = (const float*)ap->in[16]; \
    P.w_router = (const float*)ap->in[17]; P.w_gate_moe = (const float*)ap->in[18]; P.w_up_moe = (const float*)ap->in[19]; P.w_down_moe = (const float*)ap->in[20]; P.w_ple_up = (const float*)ap->in[21]; \
    P.w_ple_gate = (const float*)ap->in[22]; P.norm_final = (const float*)ap->in[23]; P.out = ap->out; P.ws = ap->ws; }
    unsigned char* ws = a.ws;
    volatile LAS unsigned* MISC = (volatile LAS unsigned*)(lds + LDS_MISC);
    if (T.tid < 64) ((LAS unsigned*)(lds + LDS_MISC))[T.tid] = 0u;
    __syncthreads();
    XcdBarrier bar; bar.bar = (unsigned*)(ws + WS_CTL) + CW_BAR; bar.x = 0; bar.st = nullptr;
    if (a.use_bar) bar = xcd_barrier_post((unsigned*)(ws + WS_CTL) + CW_BAR, MISC + 8);
    const int lo = a.ph_lo, hi = a.ph_hi, G = T.G, c = (int)blockIdx.x;
#ifndef PH_MASK
#define PH_MASK 0x1fffff
#endif
#define IN(k) ((((PH_MASK) >> (k)) & 1) && lo <= (k) && (k) < hi)
#ifndef DUP_MASK
#define DUP_MASK 0
#endif
#define REP(k) for (int rep_ = 0; rep_ < ((((DUP_MASK) >> (k)) & 1) + 1); ++rep_)
#define SEAM(k) do { if (IN((k) + 1)) xcd_barrier(bar); } while (0)
    bf16_t* hbX = (bf16_t*)(ws + WS_HBX); bf16_t* hbY = (bf16_t*)(ws + WS_HBY);
    float* partA = (float*)(ws + WS_PARTA); float* partB = (float*)(ws + WS_PARTB);

    if (IN(0)) { LOAD_P(); for (int rep_ = 0; rep_ < ((DUP_MASK & 1) ? T0_REPS : 0) + 1; ++rep_) t0_prologue(T, P, (DUP_MASK & 1) && rep_ < T0_REPS ? T0_SEL : 0xff); SEAM(0); }
    if (IN(1)) { LOAD_P(); (void)P;
        SchedINA S{G, c, (const char*)hbX, (const char*)(ws + WS_WIN)};
        EpiINA E{(const float*)(ws + WS_RSTD0), (const f32x2*)(ws + WS_ROPE), (bf16_t*)(ws + WS_Q), (bf16_t*)(ws + WS_KP), (bf16_t*)(ws + WS_G), (bf16_t*)(ws + WS_KT), (bf16_t*)(ws + WS_VT)};
        REP(1) gemm_phase<EpiINA, SchedINA, false, false>(lds, 1024, 1024, 16, 16, S, E, (rep_ == 0 && ((DUP_MASK >> 1) & 1)) ? 1 : 0);
        SEAM(1);
    }
    if (IN(2)) { LOAD_P(); (void)P;
#ifndef P2SEL
#define P2SEL 7
#endif
        if (P2SEL & 1) { SchedGen S{G, c, 64, 4, (const char*)(ws + WS_Q), (const char*)(ws + WS_KP), nullptr, nullptr, 524288, 512, 524288, 512, 0, 0};
          EpiStore<true> E{(bf16_t*)(ws + WS_PP), 1024, 1.f};
          gemm_phase<EpiStore<true>, SchedGen, false, false>(lds, 1024, 1024, 4, 4, S, E); }
        if (P2SEL & 2) { SchedGen S{G, c, 8, 64, (const char*)(ws + WS_VT), (const char*)(ws + WS_KT), nullptr, nullptr, 8388608, 512, 8388608, 512, 0, 1};
          EpiStore<false> E{(bf16_t*)(ws + WS_UT), 16384, 1.f};
          REP(2) gemm_phase<EpiStore<false>, SchedGen, false, false>(lds, 16384, 16384, 4, 4, S, E, (rep_ == 0 && ((DUP_MASK >> 2) & 1)) ? 1 : 0); }
        SEAM(2);
    }
    if (IN(3)) { LOAD_P(); REP(3) t_scan(T, P); SEAM(3); }
    if (IN(4)) { LOAD_P(); (void)P;
        SchedGen S{G, c, 64, 8, (const char*)(ws + WS_PP), (const char*)(ws + WS_VT), (const char*)(ws + WS_Q), (const char*)(ws + WS_ST), 524288, 512, 512, 8388608, 1, 0, 1};
        EpiR3 E{(bf16_t*)(ws + WS_O), (float*)(ws + WS_PGN)};
        REP(4) gemm_phase<EpiR3, SchedGen, true, false>(lds, 1024, 16384, 8, 4, S, E, (rep_ == 0 && ((DUP_MASK >> 4) & 1)) ? 1 : 0);
        t_gn_local(T, P);
        SEAM(4);
    }
    if (IN(5)) { LOAD_P(); (void)P;
        SchedGen S{G, c, 64, 4, (const char*)(ws + WS_O), (const char*)(ws + WS_WOA), nullptr, nullptr, 1048576, 0, 0, 1048576, 0, 0};
        EpiRes<0> E{P.x, P.out, hbX, partB, nullptr, nullptr};
        REP(5) gemm_phase<EpiRes<0>, SchedGen, false, false>(lds, 2048, 2048, 32, 32, S, E, (rep_ == 0 && ((DUP_MASK >> 5) & 1)) ? 1 : 0);
        SEAM(5);
    }
    if (IN(6)) { LOAD_P(); REP(6) pm1_convert(T, P); SEAM(6); }
    if (IN(7)) { LOAD_P(); (void)P;
        SchedGen S{G, c, 64, 22, (const char*)hbX, (const char*)(ws + WS_WGU0), nullptr, nullptr, 524288, 0, 0, 524288, 0, 0};
        EpiGU<false> E{(bf16_t*)(ws + WS_HD), 2816, partB, nullptr, nullptr};
        REP(7) gemm_phase<EpiGU<false>, SchedGen, false, false>(lds, 1024, 1024, 16, 16, S, E, (rep_ == 0 && ((DUP_MASK >> 7) & 1)) ? 1 : 0);
        SEAM(7);
    }
    if (IN(8)) { LOAD_P(); (void)P;
        SchedGen S{G, c, 64, 4, (const char*)(ws + WS_HD), (const char*)(ws + WS_WD0), nullptr, nullptr, 1441792, 0, 0, 1441792, 0, 0};
        EpiRes<0> E{P.out, P.out, hbX, partA, nullptr, nullptr};
        REP(8) gemm_phase<EpiRes<0>, SchedGen, false, false>(lds, 2816, 2816, 44, 44, S, E, (rep_ == 0 && ((DUP_MASK >> 8) & 1)) ? 1 : 0);
        { SchedGen S{G, c, 64, 4, (const char*)(ws + WS_PB), (const char*)(ws + WS_WPU0), nullptr, nullptr, 131072, 0, 0, 131072, 0, 0};
          EpiStore<false> E{(bf16_t*)(ws + WS_U), 1024, 1.f};
          gemm_phase<EpiStore<false>, SchedGen, false, false>(lds, 256, 256, 4, 4, S, E); }
        SEAM(8);
    }
    if (IN(9)) { LOAD_P(); (void)P;
        SchedGen S{G, c, 64, 4, (const char*)hbX, (const char*)(ws + WS_WPG0), nullptr, nullptr, 524288, 0, 0, 524288, 0, 0};
        EpiRes<1> E{P.out, P.out, hbY, partB, partA, (const bf16_t*)(ws + WS_U)};
        REP(9) gemm_phase<EpiRes<1>, SchedGen, false, false>(lds, 1024, 1024, 16, 16, S, E, (rep_ == 0 && ((DUP_MASK >> 9) & 1)) ? 1 : 0);
        SEAM(9);
    }
    if (IN(10)) { LOAD_P(); (void)P;
        SchedQKVB S{G, c, (const char*)hbY, (const char*)(ws + WS_WQKV)};
        EpiQKVB E{partB, (bf16_t*)(ws + WS_QB), (bf16_t*)(ws + WS_KB), (bf16_t*)(ws + WS_VBT)};
        REP(10) gemm_phase<EpiQKVB, SchedQKVB, false, false>(lds, 1024, 1024, 16, 16, S, E, (rep_ == 0 && ((DUP_MASK >> 10) & 1)) ? 1 : 0);
        SEAM(10);
    }
    if (IN(11)) { LOAD_P(); REP(11) attn_phase(T, P); SEAM(11); }
    if (IN(12)) { LOAD_P(); (void)P;
        SchedGen S{G, c, 64, 4, (const char*)(ws + WS_OB), (const char*)(ws + WS_WOB), nullptr, nullptr, 524288, 0, 0, 524288, 0, 0};
        EpiRes<0> E{P.out, P.out, nullptr, partA, nullptr, nullptr};
        REP(12) gemm_phase<EpiRes<0>, SchedGen, false, false>(lds, 1024, 1024, 16, 16, S, E, (rep_ == 0 && ((DUP_MASK >> 12) & 1)) ? 1 : 0);
        SEAM(12);
    }
    if (IN(13)) { LOAD_P(); t_router(T, P); SEAM(13); }
    if (IN(14)) { LOAD_P(); (void)P;
        SchedMoe S; S.G = G; S.c = c; S.nN = 28; S.init_counts((const unsigned*)(ws + WS_CTL) + CW_CNT);
        S.A = (const char*)(ws + WS_XS8); S.B = (const char*)(ws + WS_WGUM); S.b_e = 7340032; S.b_pn = 262144; S.a_rt = 0; S.a_e = 16777216; S.tok = nullptr;
        EpiGU<true> E{(bf16_t*)(ws + WS_HM), 3584, nullptr, (const float*)(ws + WS_MRS), (const float*)(ws + WS_MGW)};
        REP(14) gemm_phase<EpiGU<true>, SchedMoe, false, false, true>(lds, 512, 512, 8, 8, S, E, (rep_ == 0 && ((DUP_MASK >> 14) & 1)) ? 1 : 0);
        SEAM(14);
    }
    if (IN(15)) { LOAD_P(); (void)P;
        { SchedMoe S; S.G = G; S.c = c; S.nN = 4; S.init_counts((const unsigned*)(ws + WS_CTL) + CW_CNT);
          S.A = (const char*)(ws + WS_HM); S.B = (const char*)(ws + WS_WDM); S.b_e = 3670016; S.b_pn = 917504; S.a_rt = 917504; S.a_e = 0; S.tok = nullptr;
          EpiStore<false> E{(bf16_t*)(ws + WS_YM), 1024, 1.f / (F8_SH * F8_SW2)};
          REP(15) gemm_phase<EpiStore<false>, SchedMoe, false, false, true>(lds, 1792, 1792, 28, 28, S, E, (rep_ == 0 && ((DUP_MASK >> 15) & 1)) ? 1 : 0); }
        { SchedGen S{G, c, 64, 4, (const char*)(ws + WS_PB) + (size_t)M * 256 * 2, (const char*)(ws + WS_WPU1), nullptr, nullptr, 131072, 0, 0, 131072, 0, 0};
          EpiStore<false> E{(bf16_t*)(ws + WS_U), 1024, 1.f};
          gemm_phase<EpiStore<false>, SchedGen, false, false>(lds, 256, 256, 4, 4, S, E); }
        SEAM(15);
    }
    if (IN(16)) { LOAD_P(); t_combine(T, P, hbX, partB); SEAM(16); }
    if (IN(17)) { LOAD_P(); (void)P;
        SchedGen S{G, c, 64, 4, (const char*)hbX, (const char*)(ws + WS_WPG1), nullptr, nullptr, 524288, 0, 0, 524288, 0, 0};
        EpiRes<1> E{P.out, P.out, nullptr, partA, partB, (const bf16_t*)(ws + WS_U)};
        REP(17) gemm_phase<EpiRes<1>, SchedGen, false, false>(lds, 1024, 1024, 16, 16, S, E, (rep_ == 0 && ((DUP_MASK >> 17) & 1)) ? 1 : 0);
        SEAM(17);
    }
    if (IN(18)) { LOAD_P(); t_final(T, P, partA, 1.f, 0.f); }
#ifdef EXTRA_BARS
    for (int xb_ = 0; xb_ < EXTRA_BARS; ++xb_) xcd_barrier(bar);
#endif
#undef IN
#undef SEAM
}

static int g_grid = 0;
static bool setup_once() {
    if (g_grid) return g_grid > 0;
    int dev = 0, cus = 0, per_cu = 0;
    if (hipGetDevice(&dev) != hipSuccess || hipDeviceGetAttribute(&cus, hipDeviceAttributeMultiprocessorCount, dev) != hipSuccess) { fprintf(stderr, "setup: device query failed\n"); g_grid = -1; return false; }
    if (hipFuncSetAttribute((const void*)fwd, hipFuncAttributeMaxDynamicSharedMemorySize, LDS_BYTES) != hipSuccess) { fprintf(stderr, "setup: hipFuncSetAttribute failed\n"); g_grid = -1; return false; }
    if (hipOccupancyMaxActiveBlocksPerMultiprocessor(&per_cu, (const void*)fwd, 512, LDS_BYTES) != hipSuccess || per_cu < 1) fprintf(stderr, "setup: occupancy query says %d\n", per_cu);
    (void)hipGetLastError();
    g_grid = cus;
    return true;
}
static void fill_args(Args& a, void* const* d_in, float* out, unsigned char* ws) { for (int i = 0; i < 24; ++i) a.in[i] = d_in[i]; a.out = out; a.ws = ws; a.pad = 0; }
static void launch_phases(void* const* d_in, float* out, unsigned char* ws, hipStream_t st, int lo, int hi, int use_bar) {
    Args a{}; fill_args(a, d_in, out, ws); a.ph_lo = lo; a.ph_hi = hi; a.use_bar = use_bar;
    hipLaunchKernelGGL(fwd, dim3(g_grid), dim3(512), LDS_BYTES, st, a);
}
}
#if FX_MODE == 1
namespace dbg {
constexpr int NCHK = 24;
constexpr size_t SNAP_BASE = (size_t)DBG_SNAP_MIB << 20;
struct Chk { size_t off; int cols; };
__global__ void __launch_bounds__(256) k_snap(const void* src, int is_bf16, long s_row, long s_col, int cols, float* dst) {
    const long n = (long)1024 * cols;
    for (long i = (long)blockIdx.x * 256 + threadIdx.x; i < n; i += (long)gridDim.x * 256) {
        const long sr = i / cols, c = i % cols, r = sr * 16; const long e = r * s_row + c * s_col;
        float v; if (is_bf16) v = __uint_as_float((unsigned)((const unsigned short*)src)[e] << 16); else v = ((const float*)src)[e];
        dst[i] = v;
    }
}
__global__ void __launch_bounds__(256) k_cmp(const float* snap, int cols, const float* nvp, long n_row, int b, int mode, float scale, float* err) {
    const long n = (long)512 * cols; float e0 = 0.f, e1 = 0.f;
    for (long i = (long)blockIdx.x * 256 + threadIdx.x; i < n; i += (long)gridDim.x * 256) {
        const long sr = i / cols, c = i % cols, rl = sr * 16;
        float nvv = nvp[rl * n_row + c];
        if (mode == 1) { const int h = (int)(c >> 8); const float lg = log2f(1.0f - exp2f(-5.0f - (float)h)); nvv *= exp2f(-(float)((rl & 255) + 1) * lg); }
        else if (mode == 2) nvv = nvv / (1.f + __expf(-nvv));
        else if (mode == 3) nvv *= scale;
        const float f = snap[((long)b * 512 + sr) * cols + c], d = f - nvv;
        e0 += d * d; e1 += nvv * nvv;
    }
    for (int o = 1; o < 64; o <<= 1) { e0 += __shfl_xor(e0, o); e1 += __shfl_xor(e1, o); }
    if ((threadIdx.x & 63) == 0) { atomicAdd(err, e0); atomicAdd(err + 1, e1); }
}
struct UsedArr { int u[NCHK]; };
__global__ void __launch_bounds__(256) k_finalize(float* out, const float* err, UsedArr used, long n4) {
    float sc = 1.f;
    for (int k = 0; k < NCHK; ++k) if (used.u[k]) { const float e0 = err[2 * k], e1 = err[2 * k + 1]; const bool bad = !(e0 <= DBG_THR * e1); if (bad) { sc = 1.f + 0.1f * (float)(k + 1); break; } }
    for (long i = (long)blockIdx.x * 256 + threadIdx.x; i < n4; i += (long)gridDim.x * 256) { float4 v = ((float4*)out)[i]; v.x *= sc; v.y *= sc; v.z *= sc; v.w *= sc; ((float4*)out)[i] = v; }
}
static unsigned char* g_ws = nullptr; static float* g_err = nullptr; static size_t g_cur = 0;
static size_t g_off[NCHK]; static int g_cols[NCHK]; static int g_have[NCHK];
static void snap(hipStream_t st, int k, const void* src, int is_bf16, long s_row, long s_col, int cols) {
    g_off[k] = g_cur; g_cols[k] = cols; g_have[k] = 1; g_cur += (size_t)1024 * cols * 4;
    hipLaunchKernelGGL(k_snap, dim3(2048), dim3(256), 0, st, src, is_bf16, s_row, s_col, cols, (float*)(g_ws + SNAP_BASE + g_off[k]));
}
static void cmp(hipStream_t st, int k, const float* nvp, long n_row, int b, int mode, float scale) {
    if (!g_have[k]) return;
    hipLaunchKernelGGL(k_cmp, dim3(1024), dim3(256), 0, st, (const float*)(g_ws + SNAP_BASE + g_off[k]), g_cols[k], nvp, n_row, b, mode, scale, g_err + 2 * k);
}
static void hook(int pt, int b, const float* p, hipStream_t st) {
    switch (pt) {
    case 0: cmp(st, 0, p, 6144, b, 0, 1.f); cmp(st, 1, p + 1024, 6144, b, 1, 1.f); cmp(st, 2, p + 4096, 6144, b, 2, 1.f); cmp(st, 3, p + 1024, 6144, b, 1, 1.f); cmp(st, 4, p + 2048, 6144, b, 0, 1.f); break;
    case 1: cmp(st, 5, p, 2048, b, 0, 1.f); break;
    case 2: cmp(st, 6, p, 1024, b, 0, 1.f); break;
    case 3: cmp(st, 7, p, 1024, b, 0, 1.f); break;
    case 4: cmp(st, 8, p, 1024, b, 0, 1.f); break;
    case 5: cmp(st, 9, p + (size_t)8192 * 2048, 1024, b, 3, fx::C2Q); cmp(st, 10, p, 2048, b, 0, 1.f); cmp(st, 11, p + 1024, 2048, b, 0, 1.f); break;
    case 6: cmp(st, 12, p, 1024, b, 0, 1.f); break;
    case 7: cmp(st, 13, p, 1024, b, 0, 1.f); break;
    case 8: cmp(st, 14, p, 1024, b, 0, 1.f); break;
    case 9: cmp(st, 15, p, 1024, b, 0, 1.f); break;
    case 10: cmp(st, 16, p, 1024, b, 0, 1.f); break;
    default: break;
    }
}
}
#endif

extern "C" void kernel_launch(void* const* d_in, const int* in_sizes, int n_in, void* d_out, int out_size, void* d_ws, size_t ws_size, hipStream_t stream) {
    if (n_in != 24 || out_size != 2 * 8192 * 1024 || ws_size < fx::WS_END) { fprintf(stderr, "kernel_launch: unexpected shapes (n_in %d out %d ws %zu)\n", n_in, out_size, ws_size); return; }
    float* out = (float*)d_out; unsigned char* ws = (unsigned char*)d_ws;
#if FX_MODE == 0
    nv::forward(d_in, out, ws, stream);
#else
    if (!fx::setup_once()) return;
    (void)hipMemsetAsync(ws + fx::WS_CTL, 0, fx::CTL_ZERO_BYTES, stream);
#if FX_MODE == 3
    fx::launch_phases(d_in, out, ws, stream, 0, fx::NPH, 1);
#elif FX_MODE == 2
    for (int ph = 0; ph < fx::NPH; ++ph) fx::launch_phases(d_in, out, ws, stream, ph, ph + 1, 0);
#else
    using namespace fx;
    dbg::g_ws = ws; dbg::g_cur = 0; for (int k = 0; k < dbg::NCHK; ++k) dbg::g_have[k] = 0;
    dbg::g_err = (float*)(ws + dbg::SNAP_BASE - 4096);
    for (int ph = 0; ph < DBG_HI; ++ph) {
        if (DBG_SKIP7 && ph == 6) continue;
        launch_phases(d_in, out, ws, stream, ph, ph + 1, 0);
        if (DBG_SET == 0) {
            if (ph == 1) { dbg::snap(stream, 0, ws + WS_Q, 1, 1024, 1, 1024); dbg::snap(stream, 1, ws + WS_KP, 1, 1024, 1, 1024); dbg::snap(stream, 2, ws + WS_G, 1, 2048, 1, 2048);
                           dbg::snap(stream, 3, ws + WS_KT, 1, 1, 16384, 1024); dbg::snap(stream, 4, ws + WS_VT, 1, 1, 16384, 2048); }
            if (ph == 4) dbg::snap(stream, 5, ws + WS_O, 1, 2048, 1, 2048);
            if (ph == 6) dbg::snap(stream, 6, out, 0, 1024, 1, 1024);
        }
        if (DBG_SET == 2) {
            if (ph == 17) dbg::snap(stream, 14, out, 0, 1024, 1, 1024);
            if (ph == 18) dbg::snap(stream, 15, out, 0, 1024, 1, 1024);
            if (ph == 19) dbg::snap(stream, 16, out, 0, 1024, 1, 1024);
        }
        if (DBG_SET == 1) {
            if (ph == 6) dbg::snap(stream, 6, out, 0, 1024, 1, 1024);
            if (ph == 9) dbg::snap(stream, 7, out, 0, 1024, 1, 1024);
            if (ph == 10) dbg::snap(stream, 8, out, 0, 1024, 1, 1024);
            if (ph == 11) { dbg::snap(stream, 9, ws + WS_QB, 1, 1024, 1, 1024); dbg::snap(stream, 10, ws + WS_KB, 1, 1024, 1, 1024); dbg::snap(stream, 11, ws + WS_VBT, 1, 1, 16384, 1024); }
            if (ph == 12) dbg::snap(stream, 12, ws + WS_OB, 1, 1024, 1, 1024);
            if (ph == 13) dbg::snap(stream, 13, out, 0, 1024, 1, 1024);
        }
    }
    dbg::UsedArr used{}; for (int k = 0; k < dbg::NCHK; ++k) used.u[k] = dbg::g_have[k];
    (void)hipMemsetAsync(ws + dbg::SNAP_BASE - 4096, 0, 4096, stream);
    nv::g_hook = dbg::hook;
    nv::forward(d_in, out, ws, stream);
    hipLaunchKernelGGL(dbg::k_finalize, dim3(2048), dim3(256), 0, stream, out, (const float*)dbg::g_err, used, (long)2 * 8192 * 1024 / 4);
#endif
#endif
}
```
